# Optimizing an MI355X kernel written in HIP

```python
import jax, jax.numpy as jnp
from jax import lax
import numpy as np

D_MODEL = 1024
BATCH = 8
SEQ = 4096
DEPTH = 1

D_MIX = D_MODEL
RWKV_HEAD = 64
RWKV_HEADS = 8
RWKV_WIDTH = RWKV_HEADS * RWKV_HEAD
DECAY_LORA = 64
ICLR_LORA = 64
GATE_LORA = 128
MLA_HEADS = 8
MLA_NOPE = 64
MLA_ROPE = 32
MLA_V = 64
MLA_WIDTH = MLA_HEADS * MLA_V
Q_LORA = 384
KV_LORA = 256
ROPE_BASE = 10000.0
ATTN_BLOCK = 128
D_FF = 4 * D_MODEL
ALPHA = (2 * DEPTH) ** 0.25
BETA = (8 * DEPTH) ** -0.25
LN_EPS = 1e-5
RMS_EPS = 1e-6
GN_EPS = 64e-5
RWKV_SPLITS = [RWKV_WIDTH, RWKV_WIDTH, RWKV_WIDTH, DECAY_LORA, ICLR_LORA, GATE_LORA]
MLA_SPLITS = [Q_LORA, KV_LORA, MLA_ROPE]
RWKV_COLS = sum(RWKV_SPLITS)
MLA_COLS = sum(MLA_SPLITS)
IN_COLS = RWKV_COLS + MLA_COLS

kernel_name = "hymba_rwkv7_mla_deepnorm_layer"


def _split(z, sizes):
    return jnp.split(z, list(np.cumsum(sizes)[:-1]), axis=-1)


def layer_norm(x, g, b):
    xf = x.astype(jnp.float32)
    mu = jnp.mean(xf, axis=-1, keepdims=True)
    var = jnp.mean(jnp.square(xf - mu), axis=-1, keepdims=True)
    return ((xf - mu) * lax.rsqrt(var + LN_EPS)).astype(x.dtype) * g + b


def rms_norm(x, g):
    xf = x.astype(jnp.float32)
    return (xf * lax.rsqrt(jnp.mean(xf * xf, axis=-1, keepdims=True) + RMS_EPS)).astype(x.dtype) * g


def rope(z, ang):
    cos, sin = jnp.cos(ang), jnp.sin(ang)
    zf = z.astype(jnp.float32)
    z1, z2 = jnp.split(zf, 2, axis=-1)
    return jnp.concatenate([z1 * cos - z2 * sin, z2 * cos + z1 * sin], axis=-1).astype(z.dtype)


def token_shift(z):
    return jnp.pad(z, ((0, 0), (1, 0), (0, 0)))[:, :-1]


def wkv7_scan(r, w, k, v, kk, a):
    B, _, H, N = r.shape
    tm = lambda t: jnp.moveaxis(t.astype(jnp.float32), 1, 0)

    def step(S, inp):
        r_t, w_t, k_t, v_t, kk_t, a_t = inp
        sa = jnp.einsum('bhvk,bhk->bhv', S, -kk_t)
        S = (S * w_t[:, :, None, :]
             + sa[..., :, None] * (kk_t * a_t)[:, :, None, :]
             + v_t[..., :, None] * k_t[:, :, None, :])
        y = jnp.einsum('bhvk,bhk->bhv', S, r_t)
        return S, y

    S0 = jnp.zeros((B, H, N, N), jnp.float32)
    _, y = lax.scan(step, S0, (tm(r), tm(w), tm(k), tm(v), tm(kk), tm(a)))
    return jnp.moveaxis(y, 0, 1).astype(r.dtype)


def rwkv7_group(hr, shift_mu, decay_w0, decay_w2, iclr_a0, iclr_a2, gate_g2, k_k, k_a, r_k, lnx_g, lnx_b):
    B, S, _ = hr.shape
    H, N = RWKV_HEADS, RWKV_HEAD
    hr = hr + (token_shift(hr) - hr) * shift_mu
    r, k, v, xw, xa, xg = _split(hr, RWKV_SPLITS)
    w_log = -jax.nn.softplus(-(decay_w0 + jnp.tanh(xw) @ decay_w2)) - 0.5
    decay = jnp.exp(-jnp.exp(w_log.astype(jnp.float32)))
    a = jax.nn.sigmoid(iclr_a0 + xa @ iclr_a2)
    g = jax.nn.sigmoid(xg) @ gate_g2
    heads = lambda t: t.reshape(B, S, H, N)
    kk = heads(k * k_k).astype(jnp.float32)
    kk = kk / jnp.maximum(jnp.sqrt(jnp.sum(kk * kk, axis=-1, keepdims=True)), 1e-12)
    k = k * (1.0 + (a - 1.0) * k_a)
    rh, kh, vh, ah = heads(r), heads(k), heads(v), heads(a)
    y = wkv7_scan(rh, heads(decay), kh, vh, kk, ah)
    yf = y.astype(jnp.float32)
    mu = jnp.mean(yf, axis=-1, keepdims=True)
    var = jnp.mean(jnp.square(yf - mu), axis=-1, keepdims=True)
    yn = ((yf - mu) * lax.rsqrt(var + GN_EPS)).astype(y.dtype).reshape(B, S, RWKV_WIDTH) * lnx_g + lnx_b
    bonus = (jnp.sum(rh * kh * r_k, axis=-1, keepdims=True) * vh).reshape(B, S, RWKV_WIDTH)
    return (yn + bonus) * g


def causal_block_attention(q, k, v):
    B, S, H, Dq = q.shape
    Dv = v.shape[-1]
    nb = S // ATTN_BLOCK
    scale = Dq ** -0.5
    qb = jnp.moveaxis(q.reshape(B, nb, ATTN_BLOCK, H, Dq), 1, 0)
    kpos = jnp.arange(S)

    def one_block(args):
        q_blk, i = args
        s = jnp.einsum('bqhd,bkhd->bhqk', q_blk, k).astype(jnp.float32) * scale
        qpos = i * ATTN_BLOCK + jnp.arange(ATTN_BLOCK)
        s = jnp.where(kpos[None, :] <= qpos[:, None], s, -jnp.inf)
        p = jax.nn.softmax(s, axis=-1).astype(v.dtype)
        return jnp.einsum('bhqk,bkhd->bqhd', p, v)

    o = lax.map(one_block, (qb, jnp.arange(nb)))
    return jnp.moveaxis(o, 0, 1).reshape(B, S, H * Dv)


def mla_group(hm, positions, q_norm_g, w_uq, kv_norm_g, w_ukv):
    B, S, _ = hm.shape
    H = MLA_HEADS
    c_q, c_kv, k_pe = _split(hm, MLA_SPLITS)
    inv_freq = ROPE_BASE ** (-jnp.arange(0, MLA_ROPE, 2, dtype=jnp.float32) / MLA_ROPE)
    ang = positions.astype(jnp.float32)[..., None] * inv_freq
    q = (rms_norm(c_q, q_norm_g) @ w_uq).reshape(B, S, H, MLA_NOPE + MLA_ROPE)
    q_nope, q_pe = _split(q, [MLA_NOPE, MLA_ROPE])
    q_pe = rope(q_pe, ang[:, :, None, :])
    kv = (rms_norm(c_kv, kv_norm_g) @ w_ukv).reshape(B, S, H, MLA_NOPE + MLA_V)
    k_nope, v = _split(kv, [MLA_NOPE, MLA_V])
    k_pe = rope(k_pe, ang)
    q = jnp.concatenate([q_nope, q_pe], axis=-1)
    k = jnp.concatenate([k_nope, jnp.broadcast_to(k_pe[:, :, None, :], (B, S, H, MLA_ROPE))], axis=-1)
    return causal_block_attention(q, k, v)


def setup_inputs(seed: int = 0) -> dict:
    key = jax.random.key(seed)
    ks = jax.random.split(key, 26)
    f32 = jnp.float32
    nrm = lambda k, shape, s: jax.random.normal(k, shape, f32) * s
    L = DEPTH
    x = jax.random.normal(ks[0], (BATCH, SEQ, D_MODEL), f32)
    offset = jax.random.randint(ks[1], (BATCH, 1), 0, 4096, dtype=jnp.int32)
    positions = (offset + jnp.arange(SEQ, dtype=jnp.int32)[None, :]).astype(jnp.int32)
    return {
        "x": x,
        "positions": positions,
        "w_in": nrm(ks[2], (L, D_MODEL, IN_COLS), D_MODEL ** -0.5),
        "shift_mu": jax.random.uniform(ks[3], (L, RWKV_COLS), f32),
        "decay_w0": jax.random.uniform(ks[4], (L, RWKV_WIDTH), f32, -5.0, 1.0),
        "decay_w2": nrm(ks[5], (L, DECAY_LORA, RWKV_WIDTH), 0.1),
        "iclr_a0": nrm(ks[6], (L, RWKV_WIDTH), 0.5),
        "iclr_a2": nrm(ks[7], (L, ICLR_LORA, RWKV_WIDTH), 0.1),
        "gate_g2": nrm(ks[8], (L, GATE_LORA, RWKV_WIDTH), GATE_LORA ** -0.5),
        "k_k": 0.85 + nrm(ks[9], (L, RWKV_WIDTH), 0.05),
        "k_a": 1.0 + nrm(ks[10], (L, RWKV_WIDTH), 0.05),
        "r_k": nrm(ks[11], (L, RWKV_HEADS, RWKV_HEAD), 0.1),
        "lnx_g": 1.0 + nrm(ks[12], (L, RWKV_WIDTH), 0.1),
        "lnx_b": nrm(ks[13], (L, RWKV_WIDTH), 0.01),
        "q_norm_g": 1.0 + nrm(ks[14], (L, Q_LORA), 0.1),
        "w_uq": nrm(ks[15], (L, Q_LORA, MLA_HEADS * (MLA_NOPE + MLA_ROPE)), Q_LORA ** -0.5),
        "kv_norm_g": 1.0 + nrm(ks[16], (L, KV_LORA), 0.1),
        "w_ukv": nrm(ks[17], (L, KV_LORA, MLA_HEADS * (MLA_NOPE + MLA_V)), KV_LORA ** -0.5),
        "w_out": nrm(ks[18], (L, D_MIX, D_MODEL), BETA * D_MIX ** -0.5),
        "ln1_g": 1.0 + nrm(ks[19], (L, D_MODEL), 0.1),
        "ln1_b": nrm(ks[20], (L, D_MODEL), 0.01),
        "w_ffn1": nrm(ks[21], (L, D_MODEL, D_FF), D_MODEL ** -0.5),
        "w_ffn2": nrm(ks[22], (L, D_FF, D_MODEL), BETA * D_FF ** -0.5),
        "ln2_g": 1.0 + nrm(ks[23], (L, D_MODEL), 0.1),
        "ln2_b": nrm(ks[24], (L, D_MODEL), 0.01),
    }


def reference(x, positions, w_in, shift_mu, decay_w0, decay_w2, iclr_a0, iclr_a2, gate_g2, k_k, k_a, r_k,
              lnx_g, lnx_b, q_norm_g, w_uq, kv_norm_g, w_ukv, w_out, ln1_g, ln1_b, w_ffn1, w_ffn2,
              ln2_g, ln2_b):
    for l in range(DEPTH):
        h = x @ w_in[l]
        y_rwkv = rwkv7_group(h[..., :RWKV_COLS], shift_mu[l], decay_w0[l], decay_w2[l], iclr_a0[l],
                             iclr_a2[l], gate_g2[l], k_k[l], k_a[l], r_k[l], lnx_g[l], lnx_b[l])
        y_mla = mla_group(h[..., RWKV_COLS:], positions, q_norm_g[l], w_uq[l], kv_norm_g[l], w_ukv[l])
        mix = jnp.concatenate([y_rwkv, y_mla], axis=-1) @ w_out[l]
        x = layer_norm(ALPHA * x + mix, ln1_g[l], ln1_b[l])
        f = jnp.square(jax.nn.relu(x @ w_ffn1[l])) @ w_ffn2[l]
        x = layer_norm(ALPHA * x + f, ln2_g[l], ln2_b[l])
    return x
```

```cpp
#include <hip/hip_runtime.h>
#include <hip/hip_bf16.h>
#include <cstdio>
#include <cstdint>
#include <cmath>
namespace pg8 {
#define PG8_LAS __attribute__((address_space(3)))
typedef unsigned short bf16_t;
typedef short bf16x8 __attribute__((ext_vector_type(8)));
typedef float f32x4 __attribute__((ext_vector_type(4)));
typedef unsigned u32x4 __attribute__((ext_vector_type(4)));
constexpr int BM = 256, BK = 64, HALF = 128, HTB = HALF * BK * 2  , STAGE_BYTES = 8 * HTB, NXCD = 8, WGM = 8;

__host__ __device__ __forceinline__ int lds_byte(int r, int c) { const int st = (r >> 4) * 2 + (c >> 5), rr = r & 15, cc = c & 31, ob = rr * 64 + cc * 2; return st * 1024 + (ob ^ (((ob >> 9) & 1) << 5)); }
__host__ __device__ __forceinline__ void stage_rc(int b, int& R, int& C) { const int st = b / 1024, sb = b % 1024, swz = sb ^ (((sb >> 9) & 1) << 5); R = (st >> 1) * 16 + swz / 64; C = (st & 1) * 32 + (swz % 64) / 2; }
__host__ __device__ __forceinline__ int perm32(int rho) { const int n = rho >> 4, i = rho & 15; return 8 * (i >> 2) + 4 * n + (i & 3); }

struct Unit { int pm, pn; };
struct Gemm { const bf16_t* A; const bf16_t* Bt; int M, N, K, lda; };

struct StaticOrder {
    int nM, nN, nwg, G, c;
    __host__ __device__ void init(int M, int N, int G_, int c_) { nM = M / BM; nN = N / BM; nwg = nM * nN; G = G_; c = c_; }
    __host__ __device__ bool next(int i, Unit& u) const {
        const long L = (long)i * G + c; if (L >= nwg) return false;
        int wgid = (int)L; { const int q = nwg / NXCD, r = nwg % NXCD, xcd = wgid % NXCD, off = wgid / NXCD; wgid = (xcd < r ? xcd * (q + 1) : r * (q + 1) + (xcd - r) * q) + off; }
        const int nig = WGM * nN, gid = wgid / nig, fm = gid * WGM, gsz = (nM - fm) < WGM ? (nM - fm) : WGM;
        u.pm = fm + ((wgid % nig) % gsz); u.pn = (wgid % nig) / gsz; return true;
    }
    __device__ __forceinline__ void a_ready(const Unit&) const {}
    __device__ __forceinline__ void done(const Unit&) const {}
};

typedef float f32x2 __attribute__((ext_vector_type(2))); typedef __bf16 bf16x2_t __attribute__((ext_vector_type(2)));
__device__ __forceinline__ unsigned cvt_pk_bf16(float lo, float hi) { f32x2 v = {lo, hi}; bf16x2_t b = __builtin_convertvector(v, bf16x2_t); return __builtin_bit_cast(unsigned, b); }
__device__ __forceinline__ u32x4 pack8(f32x4 v0, f32x4 v1) { u32x4 w; w.x = cvt_pk_bf16(v0[0], v0[1]); w.y = cvt_pk_bf16(v0[2], v0[3]); w.z = cvt_pk_bf16(v1[0], v1[1]); w.w = cvt_pk_bf16(v1[2], v1[3]); return w; }

template <int ACT  > struct EpiBf16 {
    static constexpr bool PERM = true, AFTER_DRAIN = false;
    bf16_t* O; int ldc;
    __device__ __forceinline__ void operator()(const f32x4 (&acc)[2][2][4][2], const Unit& u, int wr, int wc, int fr, int fq) const {
        const int row0 = u.pm * BM + wr * 64 + fr; const int col0 = u.pn * BM + wc * 32 + 8 * fq;
#pragma unroll
        for (int ai = 0; ai < 2; ++ai)
#pragma unroll
            for (int m = 0; m < 4; ++m) { bf16_t* rowp = O + (size_t)(row0 + ai * HALF + m * 16) * ldc + col0;
#pragma unroll
                for (int bj = 0; bj < 2; ++bj) { f32x4 v0 = acc[ai][bj][m][0], v1 = acc[ai][bj][m][1];
                    if (ACT == 2) {
#pragma unroll
                        for (int e = 0; e < 4; ++e) { const float a = fmaxf(v0[e], 0.f), b = fmaxf(v1[e], 0.f); v0[e] = a * a; v1[e] = b * b; } }
                    *(u32x4*)(rowp + bj * HALF) = pack8(v0, v1); } }
    }
};
struct EpiQ {
    static constexpr bool PERM = true, AFTER_DRAIN = false;
    bf16_t* Q; const float* rstd; const float* cs; const float* sn; float c2;
    __device__ __forceinline__ void operator()(const f32x4 (&acc)[2][2][4][2], const Unit& u, int wr, int wc, int fr, int fq) const {
        const int row0 = u.pm * BM + wr * 64 + fr; const int col0 = u.pn * BM + wc * 32 + 8 * fq;
#pragma unroll
        for (int ai = 0; ai < 2; ++ai)
#pragma unroll
            for (int m = 0; m < 4; ++m) { const int row = row0 + ai * HALF + m * 16; const float s = rstd[row] * c2;
#pragma unroll
                for (int bj = 0; bj < 2; ++bj) { const int c = col0 + bj * HALF; const int j = c % 96;
                    f32x4 v0 = acc[ai][bj][m][0] * s, v1 = acc[ai][bj][m][1] * s;
                    if (j >= 64) { const int i0 = (j - 64) >> 1; const f32x4 cc = *(const f32x4*)(cs + (size_t)row * 16 + i0), ss = *(const f32x4*)(sn + (size_t)row * 16 + i0);
                        f32x4 a0, a1;
                        a0[0] = v0[0] * cc[0] - v0[1] * ss[0]; a0[1] = v0[1] * cc[0] + v0[0] * ss[0]; a0[2] = v0[2] * cc[1] - v0[3] * ss[1]; a0[3] = v0[3] * cc[1] + v0[2] * ss[1];
                        a1[0] = v1[0] * cc[2] - v1[1] * ss[2]; a1[1] = v1[1] * cc[2] + v1[0] * ss[2]; a1[2] = v1[2] * cc[3] - v1[3] * ss[3]; a1[3] = v1[3] * cc[3] + v1[2] * ss[3];
                        v0 = a0; v1 = a1; }
                    *(u32x4*)(Q + (size_t)row * 768 + c) = pack8(v0, v1); }
                asm volatile("" ::: "memory"); }
    }
};
struct EpiKV {
    static constexpr bool PERM = true, AFTER_DRAIN = false;
    bf16_t* Kb; bf16_t* Vb; const float* rstd;
    __device__ __forceinline__ void operator()(const f32x4 (&acc)[2][2][4][2], const Unit& u, int wr, int wc, int fr, int fq) const {
        const int row0 = u.pm * BM + wr * 64 + fr; const int col0 = u.pn * BM + wc * 32 + 8 * fq;
#pragma unroll
        for (int ai = 0; ai < 2; ++ai)
#pragma unroll
            for (int m = 0; m < 4; ++m) { const int row = row0 + ai * HALF + m * 16; const float s = rstd[row];
#pragma unroll
                for (int bj = 0; bj < 2; ++bj) { const int c = col0 + bj * HALF; const int hh = c >> 7, j = c & 127;
                    const f32x4 v0 = acc[ai][bj][m][0] * s, v1 = acc[ai][bj][m][1] * s;
                    bf16_t* dst = (j < 64) ? (Kb + (size_t)row * 768 + hh * 96 + j) : (Vb + (size_t)row * 512 + hh * 64 + (j - 64));
                    *(u32x4*)dst = pack8(v0, v1); }
                if (m & 1) asm volatile("" ::: "memory"); }
    }
};
struct EpiF32 {
    static constexpr bool PERM = false, AFTER_DRAIN = false;
    float* out; int ldc;
    __device__ __forceinline__ void operator()(const f32x4 (&acc)[2][2][4][2], const Unit& u, int wr, int wc, int fr, int fq) const {
        const int col0 = u.pn * BM + wc * 32 + 4 * fq;
#pragma unroll
        for (int ai = 0; ai < 2; ++ai)
#pragma unroll
            for (int m = 0; m < 4; ++m) { const size_t off = (size_t)(u.pm * BM + ai * HALF + wr * 64 + m * 16 + fr) * ldc + col0;
#pragma unroll
                for (int bj = 0; bj < 2; ++bj)
#pragma unroll
                    for (int n = 0; n < 2; ++n) *(f32x4*)(out + off + bj * HALF + n * 16) = acc[ai][bj][m][n]; }
    }
};

template <class Epi, class Sched, bool ALIGN_EPI = false, bool SP2 = false>
__device__ __forceinline__ void gemm_phase(PG8_LAS unsigned char* lds, const Gemm g, const Sched& S, const Epi& E, const int tid) {
    const int wid = __builtin_amdgcn_readfirstlane(tid >> 6), lane = tid & 63, wr = wid >> 2, wc = wid & 3, fr = lane & 15, fq = lane >> 4;
    const int K = g.K, nt = K / BK;
    unsigned voffA[2], voffB[2];
#pragma unroll
    for (int i = 0; i < 2; ++i) { int R, C; stage_rc(tid * 16 + i * 8192, R, C); const int Rb = Epi::PERM ? ((R & ~31) + perm32(R & 31)) : R;
        voffA[i] = (unsigned)(R * g.lda + C) * 2u; voffB[i] = (unsigned)(Rb * K + C) * 2u; }
    const size_t kstep = (size_t)(BK * 2);
    const size_t hstepB = (size_t)HALF * K * 2, hstepA = (size_t)HALF * g.lda * 2;
    const size_t tstepA = 2 * hstepA, tstepB = 2 * hstepB;
    const unsigned ldsw = (unsigned)wid * 1024u;
    const int aoff = lds_byte(wr * 64 + fr, fq * 8), boff = lds_byte(wc * 32 + fr, fq * 8);
#define PG8_SA(b, h) (((b) * 2 + (h)) * HTB)
#define PG8_SB(b, h) ((4 + (b) * 2 + (h)) * HTB)
#define PG8_STAGE(bufoff, gbase, voff) do { _Pragma("unroll") for (int _i = 0; _i < 2; ++_i) \
        __builtin_amdgcn_global_load_lds((const unsigned*)((const char*)(gbase) + (voff)[_i]), (PG8_LAS unsigned*)(lds + (bufoff) + ldsw + _i * 8192), 16, 0, 0); } while (0)
#define PG8_LDA(dst, b, h) do { _Pragma("unroll") for (int m = 0; m < 4; ++m) _Pragma("unroll") for (int k = 0; k < 2; ++k) dst[m][k] = *(const PG8_LAS bf16x8*)(lds + PG8_SA(b, h) + aoff + m * 2048 + k * 1024); } while (0)
#define PG8_LDB(dst, b, h) do { _Pragma("unroll") for (int n = 0; n < 2; ++n) _Pragma("unroll") for (int k = 0; k < 2; ++k) dst[n][k] = *(const PG8_LAS bf16x8*)(lds + PG8_SB(b, h) + boff + n * 2048 + k * 1024); } while (0)
#define PG8_MMA(ai, bj, At, Bt) do { __builtin_amdgcn_s_setprio(1); _Pragma("unroll") for (int m = 0; m < 4; ++m) _Pragma("unroll") for (int n = 0; n < 2; ++n) _Pragma("unroll") for (int k = 0; k < 2; ++k) \
        acc[ai][bj][m][n] = __builtin_amdgcn_mfma_f32_16x16x32_bf16(Bt[n][k], At[m][k], acc[ai][bj][m][n], 0, 0, 0); __builtin_amdgcn_s_setprio(0); } while (0)
#define PG8_WAIT_V(n) asm volatile("s_waitcnt vmcnt(" #n ")" ::: "memory")
#define PG8_WAIT_L(n) asm volatile("s_waitcnt lgkmcnt(" #n ")" ::: "memory")
#define PG8_BAR __builtin_amdgcn_s_barrier()
#define PG8_SCHED __builtin_amdgcn_sched_barrier(0)
    Unit cur, nxt; int ui = 0;
    if (!S.next(0, cur)) return;
    f32x4 acc[2][2][4][2];
#pragma unroll
    for (int a = 0; a < 2; ++a)
#pragma unroll
        for (int b = 0; b < 2; ++b)
#pragma unroll
            for (int m = 0; m < 4; ++m)
#pragma unroll
                for (int n = 0; n < 2; ++n) acc[a][b][m][n] = (f32x4){0.f, 0.f, 0.f, 0.f};
    bf16x8 At[4][2], B0[2][2], B1[2][2];
    const char* cA = (const char*)g.A + (size_t)cur.pm * tstepA; const char* cB = (const char*)g.Bt + (size_t)cur.pn * tstepB;
    S.a_ready(cur);
    if constexpr (SP2) {
        PG8_STAGE(PG8_SB(0, 0), cB, voffB); PG8_STAGE(PG8_SB(0, 1), cB + hstepB, voffB); PG8_STAGE(PG8_SA(0, 0), cA, voffA); PG8_STAGE(PG8_SA(0, 1), cA + hstepA, voffA);
        if (wr == 1) PG8_BAR;
        PG8_WAIT_V(2); PG8_BAR;
        PG8_STAGE(PG8_SB(1, 0), cB + kstep, voffB); PG8_STAGE(PG8_SA(1, 0), cA + kstep, voffA); PG8_STAGE(PG8_SB(1, 1), cB + hstepB + kstep, voffB);
        PG8_WAIT_V(6); PG8_BAR;
    } else {
        PG8_STAGE(PG8_SB(0, 0), cB, voffB); PG8_STAGE(PG8_SA(0, 0), cA, voffA); PG8_STAGE(PG8_SB(0, 1), cB + hstepB, voffB); PG8_STAGE(PG8_SA(0, 1), cA + hstepA, voffA);
        if (wr == 1) PG8_BAR;
        PG8_WAIT_V(4); PG8_BAR;
        PG8_STAGE(PG8_SB(1, 0), cB + kstep, voffB); PG8_STAGE(PG8_SA(1, 0), cA + kstep, voffA); PG8_STAGE(PG8_SB(1, 1), cB + hstepB + kstep, voffB);
        PG8_WAIT_V(6); PG8_BAR;
    }
    for (;;) {
        const bool has_next = S.next(ui + 1, nxt);
        const char* nA = has_next ? (const char*)g.A + (size_t)nxt.pm * tstepA : cA; const char* nB = has_next ? (const char*)g.Bt + (size_t)nxt.pn * tstepB : cB;
        for (int t = 0; t < nt; t += 2) {
            const bool last = (t == nt - 2);
            const char* a1 = cA + (size_t)(t + 1) * kstep;
            const char* a2 = last ? nA : cA + (size_t)(t + 2) * kstep; const char* b2 = last ? nB : cB + (size_t)(t + 2) * kstep;
            const char* a3 = a2 + kstep; const char* b3 = b2 + kstep;
            if (last && has_next) S.a_ready(nxt);
            if constexpr (SP2) {
            PG8_LDB(B0, 0, 0); PG8_LDB(B1, 0, 1); PG8_SCHED; PG8_LDA(At, 0, 0); PG8_STAGE(PG8_SA(1, 1), a1 + hstepA, voffA);
            PG8_WAIT_V(8); PG8_WAIT_L(0); PG8_BAR; PG8_MMA(0, 0, At, B0); PG8_MMA(0, 1, At, B1); PG8_BAR; PG8_SCHED;
            PG8_LDA(At, 0, 1); PG8_STAGE(PG8_SB(0, 0), b2, voffB); PG8_STAGE(PG8_SB(0, 1), b2 + hstepB, voffB); PG8_STAGE(PG8_SA(0, 0), a2, voffA);
            PG8_WAIT_V(8); PG8_WAIT_L(0); PG8_BAR; PG8_MMA(1, 0, At, B0); PG8_MMA(1, 1, At, B1); PG8_BAR; PG8_SCHED;
            PG8_LDB(B0, 1, 0); PG8_LDB(B1, 1, 1); PG8_SCHED; PG8_LDA(At, 1, 0); PG8_STAGE(PG8_SA(0, 1), a2 + hstepA, voffA);
            PG8_WAIT_V(8); PG8_WAIT_L(0); PG8_BAR; PG8_MMA(0, 0, At, B0); PG8_MMA(0, 1, At, B1); PG8_BAR; PG8_SCHED;
            PG8_LDA(At, 1, 1); PG8_STAGE(PG8_SB(1, 0), b3, voffB); PG8_STAGE(PG8_SB(1, 1), b3 + hstepB, voffB); PG8_STAGE(PG8_SA(1, 0), a3, voffA);
            PG8_WAIT_V(8); PG8_WAIT_L(0); PG8_BAR; PG8_MMA(1, 0, At, B0); PG8_MMA(1, 1, At, B1); PG8_BAR; PG8_SCHED;
            } else {
            PG8_LDB(B0, 0, 0); PG8_SCHED; PG8_LDA(At, 0, 0); PG8_STAGE(PG8_SA(1, 1), a1 + hstepA, voffA);
            PG8_WAIT_L(8); PG8_BAR; PG8_WAIT_L(0); PG8_MMA(0, 0, At, B0); PG8_BAR; PG8_SCHED;
            PG8_LDB(B1, 0, 1); PG8_STAGE(PG8_SB(0, 0), b2, voffB);
            PG8_BAR; PG8_WAIT_L(0); PG8_MMA(0, 1, At, B1); PG8_BAR;
            PG8_LDA(At, 0, 1); PG8_STAGE(PG8_SA(0, 0), a2, voffA);
            PG8_BAR; PG8_WAIT_L(0); PG8_MMA(1, 0, At, B0); PG8_BAR; PG8_SCHED;
            PG8_STAGE(PG8_SB(0, 1), b2 + hstepB, voffB);
            PG8_WAIT_V(6); PG8_BAR; PG8_MMA(1, 1, At, B1); PG8_BAR;
            PG8_LDB(B0, 1, 0); PG8_SCHED; PG8_LDA(At, 1, 0); PG8_STAGE(PG8_SA(0, 1), a2 + hstepA, voffA);
            PG8_WAIT_L(8); PG8_BAR; PG8_WAIT_L(0); PG8_MMA(0, 0, At, B0); PG8_BAR; PG8_SCHED;
            PG8_LDB(B1, 1, 1); PG8_STAGE(PG8_SB(1, 0), b3, voffB);
            PG8_BAR; PG8_WAIT_L(0); PG8_MMA(0, 1, At, B1); PG8_BAR;
            PG8_LDA(At, 1, 1); PG8_STAGE(PG8_SA(1, 0), a3, voffA);
            PG8_BAR; PG8_WAIT_L(0); PG8_MMA(1, 0, At, B0); PG8_BAR; PG8_SCHED;
            PG8_STAGE(PG8_SB(1, 1), b3 + hstepB, voffB);
            PG8_WAIT_V(6); PG8_BAR; PG8_MMA(1, 1, At, B1); PG8_BAR;
            }
        }
        if constexpr (ALIGN_EPI) { if (wr == 0) PG8_BAR; }
        if constexpr (!Epi::AFTER_DRAIN) { E(acc, cur, wr, wc, fr, fq); S.done(cur); }
        if (!has_next) break;
#pragma unroll
        for (int a = 0; a < 2; ++a)
#pragma unroll
            for (int b = 0; b < 2; ++b)
#pragma unroll
                for (int m = 0; m < 4; ++m)
#pragma unroll
                    for (int n = 0; n < 2; ++n) acc[a][b][m][n] = (f32x4){0.f, 0.f, 0.f, 0.f};
        cur = nxt; cA = nA; cB = nB; ++ui;
        if constexpr (ALIGN_EPI) { if (wr == 1) PG8_BAR; }
    }
    PG8_WAIT_V(0);
    if constexpr (!ALIGN_EPI) { if (wr == 0) PG8_BAR; }
    PG8_BAR;
    if constexpr (Epi::AFTER_DRAIN) { E.fused(acc, cur, wr, wc, fr, fq, lds, wid, lane); S.done(cur); }
#undef PG8_SA
#undef PG8_SB
#undef PG8_STAGE
#undef PG8_LDA
#undef PG8_LDB
#undef PG8_MMA
#undef PG8_WAIT_V
#undef PG8_WAIT_L
#undef PG8_BAR
#undef PG8_SCHED
}
}
namespace att {
#define ATT_LAS __attribute__((address_space(3)))
typedef unsigned short bf16_t;
typedef short bf16x8 __attribute__((ext_vector_type(8)));
typedef short s16x4 __attribute__((ext_vector_type(4)));
typedef float f32x16 __attribute__((ext_vector_type(16)));
typedef unsigned u32x4 __attribute__((ext_vector_type(4)));
constexpr int SEQ = 4096, QB = 256, KVB = 64;
constexpr int KP = 208, VP = 192;
constexpr int KT = KVB * KP, VT = KVB * VP;
constexpr int OFF_V = 2 * KT, OFF_SCR = 2 * KT + 2 * VT, LDS_BYTES = OFF_SCR + 8 * 256;
__device__ __forceinline__ int crow(int r, int hi) { return (r & 3) + 8 * (r >> 2) + 4 * hi; }
typedef float f32x2 __attribute__((ext_vector_type(2))); typedef __bf16 bf16x2_t __attribute__((ext_vector_type(2)));
__device__ __forceinline__ unsigned cvtpk(float lo, float hi) { f32x2 v = {lo, hi}; bf16x2_t b = __builtin_convertvector(v, bf16x2_t); return __builtin_bit_cast(unsigned, b); }
typedef short v4i16_t __attribute__((ext_vector_type(4)));
__device__ __forceinline__ s16x4 vtr(const ATT_LAS unsigned char* p) { return __builtin_bit_cast(s16x4, __builtin_amdgcn_ds_read_tr16_b64_v4i16((ATT_LAS v4i16_t*)p)); }
#define ATT_MFMA(a, b, c) __builtin_amdgcn_mfma_f32_32x32x16_bf16((a), (b), (c), 0, 0, 0)
#define ATT_PACK(P, B) __builtin_bit_cast(bf16x8, (u32x4){cvtpk(P[B], P[B + 1]), cvtpk(P[B + 2], P[B + 3]), cvtpk(P[B + 4], P[B + 5]), cvtpk(P[B + 6], P[B + 7])})

__device__ __forceinline__ void attn_unit(int b, int h, int qb, const bf16_t* __restrict__ Q, const bf16_t* __restrict__ K, const bf16_t* __restrict__ V, bf16_t* cat, ATT_LAS unsigned char* lds, const int tid) {
    const int lane = tid & 63, r = lane & 31, hi = lane >> 5; const int wid = __builtin_amdgcn_readfirstlane(tid >> 6);
    const size_t rowbase = (size_t)b * SEQ; const int q0 = qb * QB;
    bf16x8 qf[6];
    { const bf16_t* qp = Q + (rowbase + q0 + wid * 32 + r) * 768 + h * 96 + hi * 8;
#pragma unroll
      for (int s = 0; s < 6; ++s) qf[s] = *(const bf16x8*)(qp + 16 * s); }
    const int kc1 = tid + 512;
    const int krow0 = tid / 12, kch0 = tid % 12, krow1 = kc1 / 12, kch1 = kc1 % 12, vrow = tid >> 3, vch = tid & 7;
    const bf16_t* kg0 = K + (rowbase + krow0) * 768 + h * 96 + kch0 * 8;
    const bf16_t* kg1 = K + (rowbase + krow1) * 768 + h * 96 + kch1 * 8;
    const bf16_t* vg = V + (rowbase + vrow) * 512 + h * 64 + vch * 8;
    const int kd0 = krow0 * KP + kch0 * 16, kd1 = krow1 * KP + kch1 * 16, vd = vrow * VP + vch * 16;
    const bool has1 = tid < 256;
    const int NT = (q0 + QB) / KVB;
    u32x4 kr0, kr1 = {0u, 0u, 0u, 0u}, vr;
    kr0 = *(const u32x4*)kg0; if (has1) kr1 = *(const u32x4*)kg1; vr = *(const u32x4*)vg;
    *(ATT_LAS u32x4*)(lds + kd0) = kr0; if (has1) *(ATT_LAS u32x4*)(lds + kd1) = kr1; *(ATT_LAS u32x4*)(lds + OFF_V + vd) = vr;
    __syncthreads();
    float m = -1e30f, l = 0.f; f32x16 o0 = {}, o1 = {};
    ATT_LAS float* scr = (ATT_LAS float*)(lds + OFF_SCR + wid * 256);
    const int qabs = q0 + wid * 32 + r;
    const int vrd = (4 * hi + ((lane & 15) >> 2)) * VP + (((lane >> 4) & 1) * 16 + (lane & 3) * 4) * 2;
    for (int t = 0; t < NT; ++t) {
        const int cur = t & 1;
        if (t + 1 < NT) { const size_t go = (size_t)(t + 1) * KVB; kr0 = *(const u32x4*)(kg0 + go * 768); if (has1) kr1 = *(const u32x4*)(kg1 + go * 768); vr = *(const u32x4*)(vg + go * 512); }
        const ATT_LAS unsigned char* Kt = lds + cur * KT; const ATT_LAS unsigned char* Vt = lds + OFF_V + cur * VT;
        f32x16 p0 = {}, p1 = {};
#pragma unroll
        for (int s = 0; s < 6; ++s) {
            const bf16x8 a0 = *(const ATT_LAS bf16x8*)(Kt + r * KP + (16 * s + 8 * hi) * 2);
            const bf16x8 a1 = *(const ATT_LAS bf16x8*)(Kt + (r + 32) * KP + (16 * s + 8 * hi) * 2);
            p0 = ATT_MFMA(a0, qf[s], p0); p1 = ATT_MFMA(a1, qf[s], p1);
        }
        if (64 * t + 63 > q0 + wid * 32) {
            const float NEG = -__builtin_inff();
#pragma unroll
            for (int i = 0; i < 16; ++i) { const int key = 64 * t + crow(i, hi); if (key > qabs) p0[i] = NEG; if (key + 32 > qabs) p1[i] = NEG; }
        }
        float mx = fmaxf(p0[0], p1[0]);
#pragma unroll
        for (int i = 1; i < 16; ++i) mx = fmaxf(mx, fmaxf(p0[i], p1[i]));
        mx = fmaxf(mx, __shfl_xor(mx, 32));
        const float mn = fmaxf(m, mx); const float alpha = __builtin_amdgcn_exp2f(m - mn); m = mn;
        float sum = 0.f;
#pragma unroll
        for (int i = 0; i < 16; ++i) { p0[i] = __builtin_amdgcn_exp2f(p0[i] - mn); p1[i] = __builtin_amdgcn_exp2f(p1[i] - mn); sum += p0[i] + p1[i]; }
        l = l * alpha + sum;
        if (hi == 0) scr[r] = alpha;
#pragma unroll
        for (int i = 0; i < 16; ++i) { const float f = scr[crow(i, hi)]; o0[i] *= f; o1[i] *= f; }
#pragma unroll
        for (int s = 0; s < 4; ++s) {
            const bf16x8 pa = (s == 0) ? ATT_PACK(p0, 0) : (s == 1) ? ATT_PACK(p0, 8) : (s == 2) ? ATT_PACK(p1, 0) : ATT_PACK(p1, 8);
            const ATT_LAS unsigned char* vp = Vt + vrd + (16 * s) * VP;
            const s16x4 l0 = vtr(vp), h0 = vtr(vp + 8 * VP), l1 = vtr(vp + 64), h1 = vtr(vp + 8 * VP + 64);
            const bf16x8 v0 = {l0[0], l0[1], l0[2], l0[3], h0[0], h0[1], h0[2], h0[3]}, v1 = {l1[0], l1[1], l1[2], l1[3], h1[0], h1[1], h1[2], h1[3]};
            o0 = ATT_MFMA(pa, v0, o0); o1 = ATT_MFMA(pa, v1, o1);
        }
        if (t + 1 < NT) { ATT_LAS unsigned char* nb = lds + (cur ^ 1) * KT; *(ATT_LAS u32x4*)(nb + kd0) = kr0; if (has1) *(ATT_LAS u32x4*)(nb + kd1) = kr1; *(ATT_LAS u32x4*)(lds + OFF_V + (cur ^ 1) * VT + vd) = vr; }
        __syncthreads();
    }
    l += __shfl_xor(l, 32);
    if (hi == 0) scr[r] = 1.0f / l;
    bf16_t* op = cat + (rowbase + q0 + wid * 32) * 1024 + 512 + h * 64 + r;
#pragma unroll
    for (int i = 0; i < 16; ++i) { const int row = crow(i, hi); const float f = scr[row];
        const unsigned w0 = cvtpk(o0[i] * f, 0.f), w1 = cvtpk(o1[i] * f, 0.f);
        op[(size_t)row * 1024] = (bf16_t)(w0 & 0xffffu); op[(size_t)row * 1024 + 32] = (bf16_t)(w1 & 0xffffu); }
    __syncthreads();
}
#undef ATT_MFMA
#undef ATT_PACK
}
#define GAS __attribute__((address_space(1)))
#define LAS __attribute__((address_space(3)))
typedef unsigned short bf16;
typedef unsigned v4u __attribute__((ext_vector_type(4)));
typedef float f32x4 __attribute__((ext_vector_type(4)));
typedef short bf16x8 __attribute__((ext_vector_type(8)));
typedef GAS unsigned gu32;
typedef GAS unsigned long long gu64;
#define RLX_AGENT __ATOMIC_RELAXED, __HIP_MEMORY_SCOPE_AGENT
#define LDS_WAIT() asm volatile("s_waitcnt lgkmcnt(0)" ::: "memory")
#define VM_WAIT() asm volatile("s_waitcnt vmcnt(0)" ::: "memory")
__device__ __forceinline__ unsigned long long rt() { return __builtin_amdgcn_s_memrealtime(); }
__device__ __forceinline__ unsigned f2bf(float f) { unsigned u = __builtin_bit_cast(unsigned, f); return (u + 0x7fffu + ((u >> 16) & 1u)) >> 16; }
__device__ __forceinline__ unsigned pk2(float lo, float hi) { return f2bf(lo) | (f2bf(hi) << 16); }

#define XB_TMO      128
#define XB_XCNT(j)  (256  + 64 * (j))
#define XB_XSUB(j)  (1280 + 64 * (j))
#define XB_XGEN(j)  (2304 + 64 * (j))
#define XB_TOP      3328
#define XB_TOPGEN   3392
#define XCD_BAR_WORDS 3456
#define XB_SPIN_CAP (1u << 18)

__device__ __forceinline__ unsigned xb_ld(unsigned* p)              { return __hip_atomic_load(p, __ATOMIC_RELAXED, __HIP_MEMORY_SCOPE_AGENT); }
__device__ __forceinline__ unsigned xb_add(unsigned* p, unsigned v) { return __hip_atomic_fetch_add(p, v, __ATOMIC_RELAXED, __HIP_MEMORY_SCOPE_AGENT); }
__device__ __forceinline__ unsigned xb_xcc_id() { return (unsigned)__builtin_amdgcn_s_getreg((3 << 11) | 20) & 0xFu; }
#define XB_SPIN(cond, bar) do { unsigned _sp = 0; while (cond) { __builtin_amdgcn_s_sleep(1); \
    if ((++_sp & 255u) == 0u) { if (xb_ld(&(bar)[XB_TMO])) break; if (_sp > XB_SPIN_CAP) { atomicAdd(&(bar)[XB_TMO], 1u); break; } } } } while (0)

struct XcdBarrier {
    unsigned* bar; unsigned x;
    volatile LAS unsigned* st;
};

__device__ __forceinline__ XcdBarrier xcd_barrier_post(unsigned* bar, volatile LAS unsigned* st, bool is_t0) {
    XcdBarrier b; b.bar = bar; b.x = xb_xcc_id(); b.st = st;
    if (is_t0) (void)xb_add(&bar[XB_XCNT(b.x)], 1u);
    return b;
}
__device__ __forceinline__ void xcd_barrier_complete(unsigned* bar, unsigned x, unsigned& nloc, unsigned& nx) {
    const unsigned G = gridDim.x * gridDim.y * gridDim.z;
    unsigned sum, cnt, mine, sp = 0u;
    for (;;) {
        sum = 0u; cnt = 0u; mine = 0u;
#pragma unroll
        for (unsigned j = 0; j < 16; ++j) { const unsigned c = xb_ld(&bar[XB_XCNT(j)]); sum += c; cnt += (c > 0u) ? 1u : 0u; mine = (j == x) ? c : mine; }
        if (sum == G) break;
        __builtin_amdgcn_s_sleep(1);
        if ((++sp & 255u) == 0u) { if (xb_ld(&bar[XB_TMO])) break; if (sp > XB_SPIN_CAP) { atomicAdd(&bar[XB_TMO], 1u); break; } }
    }
    nloc = mine > 0u ? mine : 1u; nx = cnt > 0u ? cnt : 1u;
}

__device__ __forceinline__ void xcd_barrier(const XcdBarrier& b, bool is_t0) {
    asm volatile("s_waitcnt vmcnt(0)" ::: "memory");
    __syncthreads();
    if (is_t0) {
        unsigned* bar = b.bar;
        __builtin_amdgcn_s_waitcnt(0);
        unsigned nloc = b.st[0], nx = b.st[1];
        if (nloc == 0u) { xcd_barrier_complete(bar, b.x, nloc, nx); b.st[0] = nloc; b.st[1] = nx; }
        const unsigned old = xb_add(&bar[XB_XSUB(b.x)], 1u);
        const unsigned gen = old / nloc;
        if (old + 1u == (gen + 1u) * nloc) {
            __builtin_amdgcn_fence(__ATOMIC_RELEASE, "agent");
            asm volatile("s_waitcnt vmcnt(0)" ::: "memory");
            const unsigned og = xb_add(&bar[XB_TOP], 1u);
            const unsigned tg = og / nx;
            if (og + 1u == (tg + 1u) * nx) xb_add(&bar[XB_TOPGEN], 1u);
            else XB_SPIN(xb_ld(&bar[XB_TOPGEN]) == tg, bar);
            __builtin_amdgcn_fence(__ATOMIC_ACQUIRE, "agent");
            xb_add(&bar[XB_XGEN(b.x)], 1u);
            asm volatile("s_waitcnt vmcnt(0)" ::: "memory");
        } else {
            XB_SPIN(xb_ld(&bar[XB_XGEN(b.x)]) == gen, bar);
            __builtin_amdgcn_fence(__ATOMIC_ACQUIRE, "agent");
            asm volatile("s_waitcnt vmcnt(0)" ::: "memory");
        }
    }
    __syncthreads();
}
constexpr int NWAVES = 8;
constexpr int BATCH = 8, SEQ = 4096, DM = 1024, M = BATCH * SEQ;
constexpr int IN_COLS = 2464, HP = 2560;
constexpr int RW_COLS = 1792, CQ_OFF = 1792, CKV_OFF = 2176, KPE_OFF = 2432;
constexpr int QL = 384, KVL = 256, NQ = 768, NKV = 1024, FF = 4096;
constexpr float ALPHA = 1.189207115002721f;
constexpr float LN_EPS = 1e-5f, RMS_EPS = 1e-6f, GN_EPS = 64e-5f;
constexpr float ATT_C2 = 0.10206207261596577f * 1.4426950408889634f;

constexpr size_t MiB = 1u << 20;
constexpr size_t WS_CTL = 0, CTL_ZERO_BYTES = 1 * MiB;
constexpr size_t WS_WIN = 1 * MiB;
constexpr size_t WS_WUQ = 6 * MiB;
constexpr size_t WS_WUKV = 7 * MiB;
constexpr size_t WS_WOUT = 8 * MiB;
constexpr size_t WS_WF1 = 10 * MiB;
constexpr size_t WS_WF2 = 18 * MiB;
constexpr size_t WS_RSTDQ = 27 * MiB, WS_RSTDKV = 27 * MiB + 256 * 1024;
constexpr size_t WS_COS = 28 * MiB, WS_SIN = 30 * MiB;
constexpr size_t WS_XB = 32 * MiB;
constexpr size_t WS_CAT = 32 * MiB;
constexpr size_t WS_HB = 96 * MiB;
constexpr size_t WS_Q = 256 * MiB, WS_K = 304 * MiB, WS_V = 352 * MiB;
constexpr size_t WS_MIX = 96 * MiB;
constexpr size_t WS_X1B = 32 * MiB;
constexpr size_t WS_HID = 256 * MiB;
constexpr size_t WS_RW = 256 * MiB;
constexpr size_t WS_END = 512 * MiB;
constexpr int CW_TMO = 0, CW_CODE = 1, CW_BAR = 4096;

struct Frame {
    LAS unsigned char* lds;
    volatile LAS unsigned* MISC;
    gu32* ctl;
    int wave;
    int vcu, G;
};
constexpr int RING_OFF = 0, RING_BYTES = 131072;
constexpr int LDSCTL_OFF = RING_BYTES, MISC_OFF = LDSCTL_OFF + 320;
constexpr int LDS_BYTES = 147456;

__device__ __forceinline__ float wave_sum(float v) {
#pragma unroll
    for (int o = 1; o < 64; o <<= 1) v += __shfl_xor(v, o);
    return v;
}
__device__ __forceinline__ float bf2f(unsigned short b) { return __uint_as_float((unsigned)b << 16); }
template <class RowMap>
__device__ __forceinline__ void p0_transpose_item(const float* W, int K, int N, bf16* WT, const float* kscale, RowMap rm, LAS float* scr, int item, int lane) {
    const int nblk = N / 32, kb = item / nblk, nb = item % nblk, k0 = 64 * kb, n0 = 32 * nb;
#pragma unroll 8
    for (int i = 0; i < 32; ++i) { const int kk = 2 * i + (lane >> 5); float v = W[(size_t)(k0 + kk) * N + n0 + (lane & 31)]; if (kscale) v *= kscale[k0 + kk]; scr[kk * 33 + (lane & 31)] = v; }
    LDS_WAIT(); asm volatile("" ::: "memory");
    const int c = lane & 7;
#pragma unroll
    for (int j = 0; j < 4; ++j) { const int n = (lane >> 3) + 8 * j; const LAS float* s = scr + (8 * c) * 33 + n;
        v4u o; o.x = pk2(s[0 * 33], s[1 * 33]); o.y = pk2(s[2 * 33], s[3 * 33]); o.z = pk2(s[4 * 33], s[5 * 33]); o.w = pk2(s[6 * 33], s[7 * 33]);
        *(GAS v4u*)(WT + (size_t)rm(n0 + n) * K + k0 + 8 * c) = o; }
    LDS_WAIT(); asm volatile("" ::: "memory");
}
struct RmId { __device__ __forceinline__ int operator()(int n) const { return n; } };
struct RmQ {
    __device__ __forceinline__ int operator()(int n) const { const int h = n / 96, j = n % 96; if (j < 64) return n; const int i = j - 64; return h * 96 + 64 + ((i < 16) ? 2 * i : 2 * (i - 16) + 1); }
};

__device__ __forceinline__ int lane_id_opaque() { int l; asm volatile("v_mbcnt_lo_u32_b32 %0, -1, 0\n\tv_mbcnt_hi_u32_b32 %0, -1, %0" : "=v"(l)); return l; }
struct Args { const void* in[25]; float* out; unsigned char* ws; int ph_lo, ph_hi, li, pad; };

__device__ __constant__ float c_invfreq[16] = {
    1.0f, 0.5623413251903491f, 0.31622776601683794f, 0.1778279410038923f, 0.1f, 0.05623413251903491f, 0.03162277660168379f, 0.01778279410038923f,
    0.01f, 0.005623413251903491f, 0.0031622776601683794f, 0.0017782794100389228f, 0.001f, 0.0005623413251903491f, 0.00031622776601683794f, 0.00017782794100389227f };

__device__ __forceinline__ void ln_row(const float* a, const float* b, const float* g, const float* be, float* of, bf16* ob, int lane) {
    const GAS f32x4* ar = (const GAS f32x4*)a + lane; const GAS f32x4* br = (const GAS f32x4*)b + lane;
    f32x4 v[4]; float s = 0.f;
#pragma unroll
    for (int j = 0; j < 4; ++j) { v[j] = ar[64 * j] * ALPHA + br[64 * j]; s += (v[j].x + v[j].y) + (v[j].z + v[j].w); }
    const float mean = wave_sum(s) * (1.f / DM); float s2 = 0.f;
#pragma unroll
    for (int j = 0; j < 4; ++j) { v[j] = v[j] - mean; s2 += (v[j].x * v[j].x + v[j].y * v[j].y) + (v[j].z * v[j].z + v[j].w * v[j].w); }
    const float rstd = 1.f / sqrtf(wave_sum(s2) * (1.f / DM) + LN_EPS);
#pragma unroll
    for (int j = 0; j < 4; ++j) { const f32x4 gg = ((const GAS f32x4*)g)[lane + 64 * j], bb = ((const GAS f32x4*)be)[lane + 64 * j]; const f32x4 o = v[j] * rstd * gg + bb;
        ((GAS f32x4*)of)[lane + 64 * j] = o;
        if (ob) ((GAS unsigned long long*)ob)[lane + 64 * j] = (unsigned long long)pk2(o.x, o.y) | ((unsigned long long)pk2(o.z, o.w) << 32); }
}

enum { PH_PRO = 0, PH_HGEMM, PH_MLAPREP, PH_QGEMM, PH_KVGEMM, PH_ATTN, PH_OUTGEMM, PH_LN1, PH_F1, PH_F2, PH_LN2, PH_COUNT };

__global__ void __launch_bounds__(NWAVES * 64, 2) skel_fwd(Args args) {
    extern __shared__ __attribute__((aligned(16))) unsigned char lds[];
    Frame F;
    F.lds = (LAS unsigned char*)lds;
    F.MISC = (volatile LAS unsigned*)(F.lds + MISC_OFF);
    F.wave = __builtin_amdgcn_readfirstlane(threadIdx.x >> 6);
#define LANE_() lane_id_opaque()
#define TID_() (F.wave * 64 + LANE_())
    F.G = gridDim.x; { const int bx = blockIdx.x; F.vcu = (F.G % 8 == 0) ? (bx % 8) * (F.G / 8) + bx / 8 : bx; }
    unsigned char* ws = args.ws;
    F.ctl = (gu32*)(ws + WS_CTL);
#define INF(i) ((const float*)args.in[i])
#define WSB(off) ((bf16*)(ws + (off)))
#define WSF(off) ((float*)(ws + (off)))
    for (int u = TID_(); u < (LDS_BYTES - LDSCTL_OFF) / 4; u += NWAVES * 64) ((LAS unsigned*)(F.lds + LDSCTL_OFF))[u] = 0u;
    __syncthreads();
    XcdBarrier bar; bar.bar = (unsigned*)(F.ctl + CW_BAR); bar.x = 0; bar.st = nullptr;
    const bool one_launch = (args.ph_hi - args.ph_lo) > 1;
    if (one_launch) bar = xcd_barrier_post((unsigned*)(F.ctl + CW_BAR), F.MISC + 8, TID_() == 0);
    const int lo = args.ph_lo, hi = args.ph_hi;
#ifndef PH_MASK
#define PH_MASK 0xffff
#endif
#define IN(k) (((PH_MASK >> (k)) & 1) && lo <= (k) && (k) < hi)
#define SEAM(k) do { if (IN(k) && IN((k) + 1)) xcd_barrier(bar, TID_() == 0); } while (0)
    const int gw = F.vcu * NWAVES + F.wave, NGW = F.G * NWAVES;

    if (IN(PH_PRO)) {
        LAS float* scr = (LAS float*)(F.lds + RING_OFF + F.wave * 16384);
        constexpr int I_IN = (DM / 64) * (IN_COLS / 32), I_UQ = (QL / 64) * (NQ / 32), I_UKV = (KVL / 64) * (NKV / 32), I_OUT = (DM / 64) * (DM / 32), I_F1 = (DM / 64) * (FF / 32), I_F2 = (FF / 64) * (DM / 32);
        constexpr int NITEMS = I_IN + I_UQ + I_UKV + I_OUT + I_F1 + I_F2;
        for (int it = gw; it < NITEMS; it += NGW) {
            int r = it;
            if (r < I_IN) { p0_transpose_item(INF(2), DM, IN_COLS, WSB(WS_WIN), nullptr, RmId(), scr, r, LANE_()); continue; } r -= I_IN;
            if (r < I_UQ) { p0_transpose_item(INF(15), QL, NQ, WSB(WS_WUQ), INF(14), RmQ(), scr, r, LANE_()); continue; } r -= I_UQ;
            if (r < I_UKV) { p0_transpose_item(INF(17), KVL, NKV, WSB(WS_WUKV), INF(16), RmId(), scr, r, LANE_()); continue; } r -= I_UKV;
            if (r < I_OUT) { p0_transpose_item(INF(18), DM, DM, WSB(WS_WOUT), nullptr, RmId(), scr, r, LANE_()); continue; } r -= I_OUT;
            if (r < I_F1) { p0_transpose_item(INF(21), DM, FF, WSB(WS_WF1), nullptr, RmId(), scr, r, LANE_()); continue; } r -= I_F1;
            p0_transpose_item(INF(22), FF, DM, WSB(WS_WF2), nullptr, RmId(), scr, r, LANE_());
        }
        { const size_t n16 = (size_t)(HP - IN_COLS) * DM * 2 / 16; GAS v4u* z = (GAS v4u*)(WSB(WS_WIN) + (size_t)IN_COLS * DM);
          for (size_t i = (size_t)F.vcu * (NWAVES * 64) + TID_(); i < n16; i += (size_t)F.G * NWAVES * 64) z[i] = (v4u){0u, 0u, 0u, 0u}; }
        { const size_t n8 = (size_t)M * DM / 8; const GAS f32x4* xs = (const GAS f32x4*)INF(0); GAS v4u* xd = (GAS v4u*)WSB(WS_XB);
          for (size_t i = (size_t)F.vcu * (NWAVES * 64) + TID_(); i < n8; i += (size_t)F.G * NWAVES * 64) { const f32x4 a = xs[2 * i], b = xs[2 * i + 1];
              v4u o; o.x = pk2(a.x, a.y); o.y = pk2(a.z, a.w); o.z = pk2(b.x, b.y); o.w = pk2(b.z, b.w); xd[i] = o; } }
    }
    SEAM(PH_PRO);
    if (IN(PH_HGEMM)) {
        pg8::Gemm g{WSB(WS_XB), WSB(WS_WIN), M, HP, DM, DM}; pg8::StaticOrder S; S.init(M, HP, F.G, (int)blockIdx.x);
        pg8::EpiBf16<0> E{WSB(WS_HB), HP};
        pg8::gemm_phase<pg8::EpiBf16<0>, pg8::StaticOrder, true, true>(F.lds + RING_OFF, g, S, E, TID_());
    }
    SEAM(PH_HGEMM);
    if (IN(PH_MLAPREP)) {
        float* RSTDQ = WSF(WS_RSTDQ); float* RSTDKV = WSF(WS_RSTDKV); float* COS = WSF(WS_COS); float* SIN = WSF(WS_SIN); bf16* KB = WSB(WS_K); const int* positions = (const int*)args.in[1];
        for (int m = gw; m < M; m += NGW) {
            const bf16* hr = WSB(WS_HB) + (size_t)m * HP;
            float sq = 0.f, skv = 0.f;
#pragma unroll
            for (int j = 0; j < 6; ++j) { const float v = bf2f(hr[CQ_OFF + LANE_() + 64 * j]); sq += v * v; }
#pragma unroll
            for (int j = 0; j < 4; ++j) { const float v = bf2f(hr[CKV_OFF + LANE_() + 64 * j]); skv += v * v; }
            sq = wave_sum(sq); skv = wave_sum(skv);
            if (LANE_() == 0) { RSTDQ[m] = 1.0f / sqrtf(sq * (1.f / QL) + RMS_EPS); RSTDKV[m] = 1.0f / sqrtf(skv * (1.f / KVL) + RMS_EPS); }
            if (LANE_() < 16) {
                const int i = LANE_(); const float ang = (float)positions[m] * c_invfreq[i]; float sn, cs; sincosf(ang, &sn, &cs);
                COS[(size_t)m * 16 + i] = cs; SIN[(size_t)m * 16 + i] = sn;
                const float z1 = bf2f(hr[KPE_OFF + i]), z2 = bf2f(hr[KPE_OFF + 16 + i]);
                const unsigned w = pk2(z1 * cs - z2 * sn, z2 * cs + z1 * sn);
#pragma unroll
                for (int h = 0; h < 8; ++h) *(GAS unsigned*)(KB + (size_t)m * 768 + h * 96 + 64 + 2 * i) = w;
            }
        }
    }
    SEAM(PH_MLAPREP);
    if (IN(PH_QGEMM)) {
        pg8::Gemm g{WSB(WS_HB) + CQ_OFF, WSB(WS_WUQ), M, NQ, QL, HP}; pg8::StaticOrder S; S.init(M, NQ, F.G, (int)blockIdx.x);
        pg8::EpiQ E{WSB(WS_Q), WSF(WS_RSTDQ), WSF(WS_COS), WSF(WS_SIN), ATT_C2};
        pg8::gemm_phase<pg8::EpiQ, pg8::StaticOrder, true, true>(F.lds + RING_OFF, g, S, E, TID_());
    }
    SEAM(PH_QGEMM);
    if (IN(PH_KVGEMM)) {
        pg8::Gemm g{WSB(WS_HB) + CKV_OFF, WSB(WS_WUKV), M, NKV, KVL, HP}; pg8::StaticOrder S; S.init(M, NKV, F.G, (int)blockIdx.x);
        pg8::EpiKV E{WSB(WS_K), WSB(WS_V), WSF(WS_RSTDKV)};
        pg8::gemm_phase<pg8::EpiKV, pg8::StaticOrder, true, true>(F.lds + RING_OFF, g, S, E, TID_());
    }
    SEAM(PH_KVGEMM);
    if (IN(PH_ATTN)) {
        for (int i = 0; i < 4; ++i) {
            const int bh = F.vcu >> 2, s = F.vcu & 3; const int qb = (i == 0) ? s : (i == 1) ? 7 - s : (i == 2) ? 8 + s : 15 - s;
            if (F.vcu < 256) att::attn_unit(bh >> 3, bh & 7, qb, WSB(WS_Q), WSB(WS_K), WSB(WS_V), WSB(WS_CAT), F.lds + RING_OFF, TID_());
        }
    }
    SEAM(PH_ATTN);
    if (IN(PH_OUTGEMM)) {
        pg8::Gemm g{WSB(WS_CAT), WSB(WS_WOUT), M, DM, DM, DM}; pg8::StaticOrder S; S.init(M, DM, F.G, (int)blockIdx.x);
        pg8::EpiF32 E{WSF(WS_MIX), DM};
        pg8::gemm_phase<pg8::EpiF32, pg8::StaticOrder, true, true>(F.lds + RING_OFF, g, S, E, TID_());
    }
    SEAM(PH_OUTGEMM);
    if (IN(PH_LN1)) { for (int m = gw; m < M; m += NGW) ln_row(INF(0) + (size_t)m * DM, WSF(WS_MIX) + (size_t)m * DM, INF(19), INF(20), args.out + (size_t)m * DM, WSB(WS_X1B) + (size_t)m * DM, LANE_()); }
    SEAM(PH_LN1);
    if (IN(PH_F1)) {
        pg8::Gemm g{WSB(WS_X1B), WSB(WS_WF1), M, FF, DM, DM}; pg8::StaticOrder S; S.init(M, FF, F.G, (int)blockIdx.x);
        pg8::EpiBf16<2> E{WSB(WS_HID), FF};
        pg8::gemm_phase<pg8::EpiBf16<2>, pg8::StaticOrder, true, true>(F.lds + RING_OFF, g, S, E, TID_());
    }
    SEAM(PH_F1);
    if (IN(PH_F2)) {
        pg8::Gemm g{WSB(WS_HID), WSB(WS_WF2), M, DM, FF, FF}; pg8::StaticOrder S; S.init(M, DM, F.G, (int)blockIdx.x);
        pg8::EpiF32 E{WSF(WS_MIX), DM};
        pg8::gemm_phase<pg8::EpiF32, pg8::StaticOrder, true, true>(F.lds + RING_OFF, g, S, E, TID_());
    }
    SEAM(PH_F2);
    if (IN(PH_LN2)) { for (int m = gw; m < M; m += NGW) ln_row(args.out + (size_t)m * DM, WSF(WS_MIX) + (size_t)m * DM, INF(23), INF(24), args.out + (size_t)m * DM, nullptr, LANE_()); }
#undef IN
#undef SEAM
}
constexpr int MH = M / 2;
constexpr size_t RWN = (size_t)MH * 512;
__global__ void __launch_bounds__(512) rwkv_prep_naive(const bf16* HBp, int tok0, const float* mu, const float* w0, const float* W2, const float* a0, const float* A2, const float* G2,
                                                       const float* k_k, const float* k_a, float* RW) {
    const int tl = blockIdx.x, t = tok0 + tl, c = threadIdx.x;
    __shared__ float hs[RW_COLS];
    const bool first = (t % SEQ) == 0;
    for (int col = c; col < RW_COLS; col += 512) { const float cur = bf2f(HBp[(size_t)t * HP + col]); const float prev = first ? 0.f : bf2f(HBp[(size_t)(t - 1) * HP + col]); hs[col] = cur + (prev - cur) * mu[col]; }
    __syncthreads();
    const float r = hs[c], k = hs[512 + c], v = hs[1024 + c];
    float dw = 0.f, da = 0.f, g = 0.f;
    for (int j = 0; j < 64; ++j) { dw += tanhf(hs[1536 + j]) * W2[j * 512 + c]; da += hs[1600 + j] * A2[j * 512 + c]; }
    for (int j = 0; j < 128; ++j) g += (1.f / (1.f + expf(-hs[1664 + j]))) * G2[j * 512 + c];
    const float z = -(w0[c] + dw); const float sp = (z > 20.f) ? z : log1pf(expf(z));
    const float wlog = -sp - 0.5f; const float decay = expf(-expf(wlog));
    const float a = 1.f / (1.f + expf(-(a0[c] + da)));
    float kk = k * k_k[c]; const float ss = wave_sum(kk * kk); kk = kk / fmaxf(sqrtf(ss), 1e-12f);
    const float k2 = k * (1.f + (a - 1.f) * k_a[c]);
    const size_t idx = (size_t)tl * 512 + c;
    RW[idx] = r; RW[RWN + idx] = decay; RW[2 * RWN + idx] = k2; RW[3 * RWN + idx] = v; RW[4 * RWN + idx] = kk; RW[5 * RWN + idx] = a; RW[6 * RWN + idx] = g;
}
__global__ void __launch_bounds__(256) rwkv_scan_naive(const float* RW, float* Y) {
    const int blk = blockIdx.x, vq = blk & 3, h = (blk >> 2) & 7, bl = blk >> 5, tid = threadIdx.x, vl = tid >> 4, kg = tid & 15, v = vq * 16 + vl, k0 = kg * 4;
    const float* R = RW; const float* Wd = RW + RWN; const float* K2 = RW + 2 * RWN; const float* Vv = RW + 3 * RWN; const float* KK = RW + 4 * RWN; const float* A = RW + 5 * RWN;
    float S0 = 0.f, S1 = 0.f, S2 = 0.f, S3 = 0.f;
#pragma unroll 4
    for (int t = 0; t < SEQ; ++t) {
        const size_t base = ((size_t)bl * SEQ + t) * 512 + h * 64;
        const float4 kk = *(const float4*)(KK + base + k0), w = *(const float4*)(Wd + base + k0), a = *(const float4*)(A + base + k0), k = *(const float4*)(K2 + base + k0), r = *(const float4*)(R + base + k0);
        const float vv = Vv[base + v];
        float sa = -(S0 * kk.x + S1 * kk.y + S2 * kk.z + S3 * kk.w);
        sa += __shfl_xor(sa, 1); sa += __shfl_xor(sa, 2); sa += __shfl_xor(sa, 4); sa += __shfl_xor(sa, 8);
        S0 = S0 * w.x + sa * (kk.x * a.x) + vv * k.x; S1 = S1 * w.y + sa * (kk.y * a.y) + vv * k.y; S2 = S2 * w.z + sa * (kk.z * a.z) + vv * k.z; S3 = S3 * w.w + sa * (kk.w * a.w) + vv * k.w;
        float y = S0 * r.x + S1 * r.y + S2 * r.z + S3 * r.w;
        y += __shfl_xor(y, 1); y += __shfl_xor(y, 2); y += __shfl_xor(y, 4); y += __shfl_xor(y, 8);
        if (kg == 0) Y[base + v] = y;
    }
}
__global__ void __launch_bounds__(512) rwkv_post_naive(const float* RW, const float* Y, int tok0, const float* r_k, const float* lnx_g, const float* lnx_b, bf16* CATp) {
    const int tl = blockIdx.x, c = threadIdx.x; const size_t idx = (size_t)tl * 512 + c;
    const float y = Y[idx]; const float mean = wave_sum(y) * (1.f / 64.f); const float d = y - mean; const float var = wave_sum(d * d) * (1.f / 64.f);
    const float yn = d * (1.0f / sqrtf(var + GN_EPS)) * lnx_g[c] + lnx_b[c];
    const float s = wave_sum(RW[idx] * RW[2 * RWN + idx] * r_k[c]);
    const float o = (yn + s * RW[3 * RWN + idx]) * RW[6 * RWN + idx];
    CATp[(size_t)(tok0 + tl) * 1024 + c] = (bf16)f2bf(o);
}

extern "C" void kernel_launch(void* const* d_in, const int* in_sizes, int n_in, void* d_out, int out_size, void* d_ws, size_t ws_size, hipStream_t stream) {
    static int grid = 0;
    if (grid == 0) {
        if (n_in != 25 || in_sizes[0] != M * DM || out_size != M * DM || ws_size < WS_END) { fprintf(stderr, "kernel_launch: unexpected shapes: n_in %d in0 %d out %d ws %zu\n", n_in, n_in > 0 ? in_sizes[0] : -1, out_size, ws_size); grid = -1; return; }
        int dev = 0, cus = 0;
        if (hipGetDevice(&dev) != hipSuccess || hipDeviceGetAttribute(&cus, hipDeviceAttributeMultiprocessorCount, dev) != hipSuccess) { grid = -1; return; }
        if (hipFuncSetAttribute((const void*)skel_fwd, hipFuncAttributeMaxDynamicSharedMemorySize, LDS_BYTES) != hipSuccess) { fprintf(stderr, "kernel_launch: hipFuncSetAttribute failed\n"); grid = -1; return; }
        (void)hipGetLastError();
        grid = cus;
        if (grid != 256) fprintf(stderr, "kernel_launch: %d CUs (expected 256)\n", grid);
    }
    if (grid < 0) return;
    (void)hipMemsetAsync((char*)d_ws + WS_CTL, 0, CTL_ZERO_BYTES, stream);
    Args a{};
    for (int i = 0; i < 25; ++i) a.in[i] = d_in[i];
    a.out = (float*)d_out; a.ws = (unsigned char*)d_ws;
    unsigned char* ws = (unsigned char*)d_ws;
    for (int ph = 0; ph < PH_COUNT; ++ph) {
        a.ph_lo = ph; a.ph_hi = ph + 1; a.li = 0;
        hipLaunchKernelGGL(skel_fwd, dim3(grid), dim3(NWAVES * 64), LDS_BYTES, stream, a);
        if (ph == PH_HGEMM) {
            for (int half = 0; half < 2; ++half) {
                float* RW = (float*)(ws + WS_RW); float* Y = RW + 7 * RWN;
                hipLaunchKernelGGL(rwkv_prep_naive, dim3(MH), dim3(512), 0, stream, (const bf16*)(ws + WS_HB), half * MH, (const float*)d_in[3], (const float*)d_in[4], (const float*)d_in[5], (const float*)d_in[6],
                                   (const float*)d_in[7], (const float*)d_in[8], (const float*)d_in[9], (const float*)d_in[10], RW);
                hipLaunchKernelGGL(rwkv_scan_naive, dim3(128), dim3(256), 0, stream, (const float*)RW, Y);
                hipLaunchKernelGGL(rwkv_post_naive, dim3(MH), dim3(512), 0, stream, (const float*)RW, (const float*)Y, half * MH, (const float*)d_in[11], (const float*)d_in[12], (const float*)d_in[13], (bf16*)(ws + WS_CAT));
            }
        }
    }
}
```

```cpp
#include <hip/hip_runtime.h>
#include <hip/hip_bf16.h>
#include <cstdio>
#include <cstdint>
#include <cmath>
#include <cstddef>
namespace pg8 {
#define PG8_LAS __attribute__((address_space(3)))
typedef unsigned short bf16_t;
typedef short bf16x8 __attribute__((ext_vector_type(8)));
typedef float f32x4 __attribute__((ext_vector_type(4)));
typedef unsigned u32x4 __attribute__((ext_vector_type(4)));
constexpr int BM = 256, BK = 64, HALF = 128, HTB = HALF * BK * 2  , STAGE_BYTES = 8 * HTB, NXCD = 8, WGM = 8;

__host__ __device__ __forceinline__ int lds_byte(int r, int c) { const int st = (r >> 4) * 2 + (c >> 5), rr = r & 15, cc = c & 31, ob = rr * 64 + cc * 2; return st * 1024 + (ob ^ (((ob >> 9) & 1) << 5)); }
__host__ __device__ __forceinline__ void stage_rc(int b, int& R, int& C) { const int st = b / 1024, sb = b % 1024, swz = sb ^ (((sb >> 9) & 1) << 5); R = (st >> 1) * 16 + swz / 64; C = (st & 1) * 32 + (swz % 64) / 2; }
__host__ __device__ __forceinline__ int perm32(int rho) { const int n = rho >> 4, i = rho & 15; return 8 * (i >> 2) + 4 * n + (i & 3); }

struct Unit { int pm, pn; };
struct Gemm { const bf16_t* A; const bf16_t* Bt; int M, N, K, lda; };

struct StaticOrder {
    int nM, nN, nwg, G, c;
    __host__ __device__ void init(int M, int N, int G_, int c_) { nM = M / BM; nN = N / BM; nwg = nM * nN; G = G_; c = c_; }
    __host__ __device__ bool next(int i, Unit& u) const {
        const long L = (long)i * G + c; if (L >= nwg) return false;
        int wgid = (int)L; { const int q = nwg / NXCD, r = nwg % NXCD, xcd = wgid % NXCD, off = wgid / NXCD; wgid = (xcd < r ? xcd * (q + 1) : r * (q + 1) + (xcd - r) * q) + off; }
        const int nig = WGM * nN, gid = wgid / nig, fm = gid * WGM, gsz = (nM - fm) < WGM ? (nM - fm) : WGM;
        u.pm = fm + ((wgid % nig) % gsz); u.pn = (wgid % nig) / gsz; return true;
    }
    __device__ __forceinline__ void a_ready(const Unit&) const {}
    __device__ __forceinline__ void done(const Unit&) const {}
};

typedef float f32x2 __attribute__((ext_vector_type(2))); typedef __bf16 bf16x2_t __attribute__((ext_vector_type(2)));
__device__ __forceinline__ unsigned cvt_pk_bf16(float lo, float hi) { f32x2 v = {lo, hi}; bf16x2_t b = __builtin_convertvector(v, bf16x2_t); return __builtin_bit_cast(unsigned, b); }
__device__ __forceinline__ u32x4 pack8(f32x4 v0, f32x4 v1) { u32x4 w; w.x = cvt_pk_bf16(v0[0], v0[1]); w.y = cvt_pk_bf16(v0[2], v0[3]); w.z = cvt_pk_bf16(v1[0], v1[1]); w.w = cvt_pk_bf16(v1[2], v1[3]); return w; }

template <int ACT  > struct EpiBf16 {
    static constexpr bool PERM = true, AFTER_DRAIN = false;
    bf16_t* O; int ldc;
    __device__ __forceinline__ void operator()(const f32x4 (&acc)[2][2][4][2], const Unit& u, int wr, int wc, int fr, int fq) const {
        const int row0 = u.pm * BM + wr * 64 + fr; const int col0 = u.pn * BM + wc * 32 + 8 * fq;
#pragma unroll
        for (int ai = 0; ai < 2; ++ai)
#pragma unroll
            for (int m = 0; m < 4; ++m) { bf16_t* rowp = O + (size_t)(row0 + ai * HALF + m * 16) * ldc + col0;
#pragma unroll
                for (int bj = 0; bj < 2; ++bj) { f32x4 v0 = acc[ai][bj][m][0], v1 = acc[ai][bj][m][1];
                    if (ACT == 2) {
#pragma unroll
                        for (int e = 0; e < 4; ++e) { const float a = fmaxf(v0[e], 0.f), b = fmaxf(v1[e], 0.f); v0[e] = a * a; v1[e] = b * b; } }
                    *(u32x4*)(rowp + bj * HALF) = pack8(v0, v1); } }
    }
};
struct EpiKV {
    static constexpr bool PERM = true, AFTER_DRAIN = false;
    bf16_t* Kb; bf16_t* Vb;
    __device__ __forceinline__ void operator()(const f32x4 (&acc)[2][2][4][2], const Unit& u, int wr, int wc, int fr, int fq) const {
        const int row0 = u.pm * BM + wr * 64 + fr; const int col0 = u.pn * BM + wc * 32 + 8 * fq;
#pragma unroll
        for (int ai = 0; ai < 2; ++ai)
#pragma unroll
            for (int m = 0; m < 4; ++m) { const int row = row0 + ai * HALF + m * 16;
#pragma unroll
                for (int bj = 0; bj < 2; ++bj) { const int c = col0 + bj * HALF; const int hh = c >> 7, j = c & 127;
                    const f32x4 v0 = acc[ai][bj][m][0], v1 = acc[ai][bj][m][1];
                    bf16_t* dst = (j < 64) ? (Kb + (size_t)row * 768 + hh * 96 + j) : (Vb + (size_t)row * 512 + hh * 64 + (j - 64));
                    *(u32x4*)dst = pack8(v0, v1); }
                if (m & 1) asm volatile("" ::: "memory"); }
    }
};
struct EpiF32 {
    static constexpr bool PERM = false, AFTER_DRAIN = false;
    float* out; int ldc;
    __device__ __forceinline__ void operator()(const f32x4 (&acc)[2][2][4][2], const Unit& u, int wr, int wc, int fr, int fq) const {
        const int col0 = u.pn * BM + wc * 32 + 4 * fq;
#pragma unroll
        for (int ai = 0; ai < 2; ++ai)
#pragma unroll
            for (int m = 0; m < 4; ++m) { const size_t off = (size_t)(u.pm * BM + ai * HALF + wr * 64 + m * 16 + fr) * ldc + col0;
#pragma unroll
                for (int bj = 0; bj < 2; ++bj)
#pragma unroll
                    for (int n = 0; n < 2; ++n) *(f32x4*)(out + off + bj * HALF + n * 16) = acc[ai][bj][m][n]; }
    }
};

template <class Epi, class Sched, bool ALIGN_EPI = false, bool SP2 = false>
__device__ __forceinline__ void gemm_phase(PG8_LAS unsigned char* lds, const Gemm g, const Sched& S, const Epi& E, const int tid) {
    const int wid = __builtin_amdgcn_readfirstlane(tid >> 6), lane = tid & 63, wr = wid >> 2, wc = wid & 3, fr = lane & 15, fq = lane >> 4;
    const int K = g.K, nt = K / BK;
    unsigned voffA[2], voffB[2];
#pragma unroll
    for (int i = 0; i < 2; ++i) { int R, C; stage_rc(tid * 16 + i * 8192, R, C); const int Rb = Epi::PERM ? ((R & ~31) + perm32(R & 31)) : R;
        voffA[i] = (unsigned)(R * g.lda + C) * 2u; voffB[i] = (unsigned)(Rb * K + C) * 2u; }
    const size_t kstep = (size_t)(BK * 2);
    const size_t hstepB = (size_t)HALF * K * 2, hstepA = (size_t)HALF * g.lda * 2;
    const size_t tstepA = 2 * hstepA, tstepB = 2 * hstepB;
    const unsigned ldsw = (unsigned)wid * 1024u;
    const int aoff = lds_byte(wr * 64 + fr, fq * 8), boff = lds_byte(wc * 32 + fr, fq * 8);
#define PG8_SA(b, h) (((b) * 2 + (h)) * HTB)
#define PG8_SB(b, h) ((4 + (b) * 2 + (h)) * HTB)
#define PG8_STAGE(bufoff, gbase, voff) do { _Pragma("unroll") for (int _i = 0; _i < 2; ++_i) \
        __builtin_amdgcn_global_load_lds((const unsigned*)((const char*)(gbase) + (voff)[_i]), (PG8_LAS unsigned*)(lds + (bufoff) + ldsw + _i * 8192), 16, 0, 0); } while (0)
#define PG8_LDA(dst, b, h) do { _Pragma("unroll") for (int m = 0; m < 4; ++m) _Pragma("unroll") for (int k = 0; k < 2; ++k) dst[m][k] = *(const PG8_LAS bf16x8*)(lds + PG8_SA(b, h) + aoff + m * 2048 + k * 1024); } while (0)
#define PG8_LDB(dst, b, h) do { _Pragma("unroll") for (int n = 0; n < 2; ++n) _Pragma("unroll") for (int k = 0; k < 2; ++k) dst[n][k] = *(const PG8_LAS bf16x8*)(lds + PG8_SB(b, h) + boff + n * 2048 + k * 1024); } while (0)
#define PG8_MMA(ai, bj, At, Bt) do { __builtin_amdgcn_s_setprio(1); _Pragma("unroll") for (int m = 0; m < 4; ++m) _Pragma("unroll") for (int n = 0; n < 2; ++n) _Pragma("unroll") for (int k = 0; k < 2; ++k) \
        acc[ai][bj][m][n] = __builtin_amdgcn_mfma_f32_16x16x32_bf16(Bt[n][k], At[m][k], acc[ai][bj][m][n], 0, 0, 0); __builtin_amdgcn_s_setprio(0); } while (0)
#define PG8_WAIT_V(n) asm volatile("s_waitcnt vmcnt(" #n ")" ::: "memory")
#define PG8_WAIT_L(n) asm volatile("s_waitcnt lgkmcnt(" #n ")" ::: "memory")
#define PG8_BAR __builtin_amdgcn_s_barrier()
#define PG8_SCHED __builtin_amdgcn_sched_barrier(0)
    Unit cur, nxt; int ui = 0;
    if (!S.next(0, cur)) return;
    f32x4 acc[2][2][4][2];
#pragma unroll
    for (int a = 0; a < 2; ++a)
#pragma unroll
        for (int b = 0; b < 2; ++b)
#pragma unroll
            for (int m = 0; m < 4; ++m)
#pragma unroll
                for (int n = 0; n < 2; ++n) acc[a][b][m][n] = (f32x4){0.f, 0.f, 0.f, 0.f};
    bf16x8 At[4][2], B0[2][2], B1[2][2];
    const char* cA = (const char*)g.A + (size_t)cur.pm * tstepA; const char* cB = (const char*)g.Bt + (size_t)cur.pn * tstepB;
    S.a_ready(cur);
    if constexpr (SP2) {
        PG8_STAGE(PG8_SB(0, 0), cB, voffB); PG8_STAGE(PG8_SB(0, 1), cB + hstepB, voffB); PG8_STAGE(PG8_SA(0, 0), cA, voffA); PG8_STAGE(PG8_SA(0, 1), cA + hstepA, voffA);
        if (wr == 1) PG8_BAR;
        PG8_WAIT_V(2); PG8_BAR;
        PG8_STAGE(PG8_SB(1, 0), cB + kstep, voffB); PG8_STAGE(PG8_SA(1, 0), cA + kstep, voffA); PG8_STAGE(PG8_SB(1, 1), cB + hstepB + kstep, voffB);
        PG8_WAIT_V(6); PG8_BAR;
    } else {
        PG8_STAGE(PG8_SB(0, 0), cB, voffB); PG8_STAGE(PG8_SA(0, 0), cA, voffA); PG8_STAGE(PG8_SB(0, 1), cB + hstepB, voffB); PG8_STAGE(PG8_SA(0, 1), cA + hstepA, voffA);
        if (wr == 1) PG8_BAR;
        PG8_WAIT_V(4); PG8_BAR;
        PG8_STAGE(PG8_SB(1, 0), cB + kstep, voffB); PG8_STAGE(PG8_SA(1, 0), cA + kstep, voffA); PG8_STAGE(PG8_SB(1, 1), cB + hstepB + kstep, voffB);
        PG8_WAIT_V(6); PG8_BAR;
    }
    for (;;) {
        const bool has_next = S.next(ui + 1, nxt);
        const char* nA = has_next ? (const char*)g.A + (size_t)nxt.pm * tstepA : cA; const char* nB = has_next ? (const char*)g.Bt + (size_t)nxt.pn * tstepB : cB;
        for (int t = 0; t < nt; t += 2) {
            const bool last = (t == nt - 2);
            const char* a1 = cA + (size_t)(t + 1) * kstep;
            const char* a2 = last ? nA : cA + (size_t)(t + 2) * kstep; const char* b2 = last ? nB : cB + (size_t)(t + 2) * kstep;
            const char* a3 = a2 + kstep; const char* b3 = b2 + kstep;
            if (last && has_next) S.a_ready(nxt);
            if constexpr (SP2) {
            PG8_LDB(B0, 0, 0); PG8_LDB(B1, 0, 1); PG8_SCHED; PG8_LDA(At, 0, 0); PG8_STAGE(PG8_SA(1, 1), a1 + hstepA, voffA);
            PG8_WAIT_V(8); PG8_WAIT_L(0); PG8_BAR; PG8_MMA(0, 0, At, B0); PG8_MMA(0, 1, At, B1); PG8_BAR; PG8_SCHED;
            PG8_LDA(At, 0, 1); PG8_STAGE(PG8_SB(0, 0), b2, voffB); PG8_STAGE(PG8_SB(0, 1), b2 + hstepB, voffB); PG8_STAGE(PG8_SA(0, 0), a2, voffA);
            PG8_WAIT_V(8); PG8_WAIT_L(0); PG8_BAR; PG8_MMA(1, 0, At, B0); PG8_MMA(1, 1, At, B1); PG8_BAR; PG8_SCHED;
            PG8_LDB(B0, 1, 0); PG8_LDB(B1, 1, 1); PG8_SCHED; PG8_LDA(At, 1, 0); PG8_STAGE(PG8_SA(0, 1), a2 + hstepA, voffA);
            PG8_WAIT_V(8); PG8_WAIT_L(0); PG8_BAR; PG8_MMA(0, 0, At, B0); PG8_MMA(0, 1, At, B1); PG8_BAR; PG8_SCHED;
            PG8_LDA(At, 1, 1); PG8_STAGE(PG8_SB(1, 0), b3, voffB); PG8_STAGE(PG8_SB(1, 1), b3 + hstepB, voffB); PG8_STAGE(PG8_SA(1, 0), a3, voffA);
            PG8_WAIT_V(8); PG8_WAIT_L(0); PG8_BAR; PG8_MMA(1, 0, At, B0); PG8_MMA(1, 1, At, B1); PG8_BAR; PG8_SCHED;
            } else {
            PG8_LDB(B0, 0, 0); PG8_SCHED; PG8_LDA(At, 0, 0); PG8_STAGE(PG8_SA(1, 1), a1 + hstepA, voffA);
            PG8_WAIT_L(8); PG8_BAR; PG8_WAIT_L(0); PG8_MMA(0, 0, At, B0); PG8_BAR; PG8_SCHED;
            PG8_LDB(B1, 0, 1); PG8_STAGE(PG8_SB(0, 0), b2, voffB);
            PG8_BAR; PG8_WAIT_L(0); PG8_MMA(0, 1, At, B1); PG8_BAR;
            PG8_LDA(At, 0, 1); PG8_STAGE(PG8_SA(0, 0), a2, voffA);
            PG8_BAR; PG8_WAIT_L(0); PG8_MMA(1, 0, At, B0); PG8_BAR; PG8_SCHED;
            PG8_STAGE(PG8_SB(0, 1), b2 + hstepB, voffB);
            PG8_WAIT_V(6); PG8_BAR; PG8_MMA(1, 1, At, B1); PG8_BAR;
            PG8_LDB(B0, 1, 0); PG8_SCHED; PG8_LDA(At, 1, 0); PG8_STAGE(PG8_SA(0, 1), a2 + hstepA, voffA);
            PG8_WAIT_L(8); PG8_BAR; PG8_WAIT_L(0); PG8_MMA(0, 0, At, B0); PG8_BAR; PG8_SCHED;
            PG8_LDB(B1, 1, 1); PG8_STAGE(PG8_SB(1, 0), b3, voffB);
            PG8_BAR; PG8_WAIT_L(0); PG8_MMA(0, 1, At, B1); PG8_BAR;
            PG8_LDA(At, 1, 1); PG8_STAGE(PG8_SA(1, 0), a3, voffA);
            PG8_BAR; PG8_WAIT_L(0); PG8_MMA(1, 0, At, B0); PG8_BAR; PG8_SCHED;
            PG8_STAGE(PG8_SB(1, 1), b3 + hstepB, voffB);
            PG8_WAIT_V(6); PG8_BAR; PG8_MMA(1, 1, At, B1); PG8_BAR;
            }
        }
        if constexpr (ALIGN_EPI) { if (wr == 0) PG8_BAR; }
        if constexpr (!Epi::AFTER_DRAIN) { E(acc, cur, wr, wc, fr, fq); S.done(cur); }
        if (!has_next) break;
#pragma unroll
        for (int a = 0; a < 2; ++a)
#pragma unroll
            for (int b = 0; b < 2; ++b)
#pragma unroll
                for (int m = 0; m < 4; ++m)
#pragma unroll
                    for (int n = 0; n < 2; ++n) acc[a][b][m][n] = (f32x4){0.f, 0.f, 0.f, 0.f};
        cur = nxt; cA = nA; cB = nB; ++ui;
        if constexpr (ALIGN_EPI) { if (wr == 1) PG8_BAR; }
    }
    PG8_WAIT_V(0);
    if constexpr (!ALIGN_EPI) { if (wr == 0) PG8_BAR; }
    PG8_BAR;
    if constexpr (Epi::AFTER_DRAIN) { E.fused(acc, cur, wr, wc, fr, fq, lds, wid, lane); S.done(cur); }
#undef PG8_SA
#undef PG8_SB
#undef PG8_STAGE
#undef PG8_LDA
#undef PG8_LDB
#undef PG8_MMA
#undef PG8_WAIT_V
#undef PG8_WAIT_L
#undef PG8_BAR
#undef PG8_SCHED
}
}
namespace att {
#define ATT_LAS __attribute__((address_space(3)))
typedef unsigned short bf16_t;
typedef short bf16x8 __attribute__((ext_vector_type(8)));
typedef short s16x4 __attribute__((ext_vector_type(4)));
typedef float f32x16 __attribute__((ext_vector_type(16)));
typedef unsigned u32x4 __attribute__((ext_vector_type(4)));
typedef float f32x4_t __attribute__((ext_vector_type(4)));
constexpr int SEQ = 4096, QB = 256, KVB = 64;
constexpr int KP = 208, VP = 192;
constexpr int KT = KVB * KP, VT = KVB * VP;
constexpr int OFF_V = 2 * KT, OFF_SCR = 2 * KT + 2 * VT, LDS_BYTES = OFF_SCR + 8 * 256;
__device__ __forceinline__ int crow(int r, int hi) { return (r & 3) + 8 * (r >> 2) + 4 * hi; }
typedef float f32x2 __attribute__((ext_vector_type(2))); typedef __bf16 bf16x2_t __attribute__((ext_vector_type(2)));
__device__ __forceinline__ unsigned cvtpk(float lo, float hi) { f32x2 v = {lo, hi}; bf16x2_t b = __builtin_convertvector(v, bf16x2_t); return __builtin_bit_cast(unsigned, b); }
typedef short v4i16_t __attribute__((ext_vector_type(4)));
__device__ __forceinline__ s16x4 vtr(const ATT_LAS unsigned char* p) { return __builtin_bit_cast(s16x4, __builtin_amdgcn_ds_read_tr16_b64_v4i16((ATT_LAS v4i16_t*)p)); }
#define ATT_MFMA(a, b, c) __builtin_amdgcn_mfma_f32_32x32x16_bf16((a), (b), (c), 0, 0, 0)
#define ATT_PACK(P, B) __builtin_bit_cast(bf16x8, (u32x4){cvtpk(P[B], P[B + 1]), cvtpk(P[B + 2], P[B + 3]), cvtpk(P[B + 4], P[B + 5]), cvtpk(P[B + 6], P[B + 7])})

__device__ __forceinline__ void attn_unit(int b, int h, int qb, const bf16_t* __restrict__ Q, const bf16_t* __restrict__ K, const bf16_t* __restrict__ V, bf16_t* cat, const float* __restrict__ cs, const float* __restrict__ sn, ATT_LAS unsigned char* lds, const int tid) {
    const int lane = tid & 63, r = lane & 31, hi = lane >> 5; const int wid = __builtin_amdgcn_readfirstlane(tid >> 6);
    const size_t rowbase = (size_t)b * SEQ; const int q0 = qb * QB;
    bf16x8 qf[6];
    { const bf16_t* qp = Q + (rowbase + q0 + wid * 32 + r) * 768 + h * 96 + hi * 8;
#pragma unroll
      for (int s = 0; s < 6; ++s) qf[s] = *(const bf16x8*)(qp + 16 * s);
      const size_t qrow = rowbase + q0 + wid * 32 + r;
#pragma unroll
      for (int s = 4; s < 6; ++s) { const int i0 = 8 * (s - 4) + 4 * hi; const f32x4_t cc = *(const f32x4_t*)(cs + qrow * 16 + i0), ss = *(const f32x4_t*)(sn + qrow * 16 + i0);
          u32x4 w = __builtin_bit_cast(u32x4, qf[s]);
#pragma unroll
          for (int e = 0; e < 4; ++e) { const float z1 = __uint_as_float(w[e] << 16), z2 = __uint_as_float(w[e] & 0xffff0000u); w[e] = cvtpk(z1 * cc[e] - z2 * ss[e], z2 * cc[e] + z1 * ss[e]); }
          qf[s] = __builtin_bit_cast(bf16x8, w); } }
    const int kc1 = tid + 512;
    const int krow0 = tid / 12, kch0 = tid % 12, krow1 = kc1 / 12, kch1 = kc1 % 12, vrow = tid >> 3, vch = tid & 7;
    const bf16_t* kg0 = K + (rowbase + krow0) * 768 + h * 96 + kch0 * 8;
    const bf16_t* kg1 = K + (rowbase + krow1) * 768 + h * 96 + kch1 * 8;
    const bf16_t* vg = V + (rowbase + vrow) * 512 + h * 64 + vch * 8;
    const int kd0 = krow0 * KP + kch0 * 16, kd1 = krow1 * KP + kch1 * 16, vd = vrow * VP + vch * 16;
    const bool has1 = tid < 256;
    const int NT = (q0 + QB) / KVB;
    u32x4 kr0, kr1 = {0u, 0u, 0u, 0u}, vr;
    kr0 = *(const u32x4*)kg0; if (has1) kr1 = *(const u32x4*)kg1; vr = *(const u32x4*)vg;
    *(ATT_LAS u32x4*)(lds + kd0) = kr0; if (has1) *(ATT_LAS u32x4*)(lds + kd1) = kr1; *(ATT_LAS u32x4*)(lds + OFF_V + vd) = vr;
    __syncthreads();
    float m = -1e30f, l = 0.f; f32x16 o0 = {}, o1 = {};
    ATT_LAS float* scr = (ATT_LAS float*)(lds + OFF_SCR + wid * 256);
    const int qabs = q0 + wid * 32 + r;
    const int vrd = (4 * hi + ((lane & 15) >> 2)) * VP + (((lane >> 4) & 1) * 16 + (lane & 3) * 4) * 2;
    for (int t = 0; t < NT; ++t) {
        const int cur = t & 1;
        if (t + 1 < NT) { const size_t go = (size_t)(t + 1) * KVB; kr0 = *(const u32x4*)(kg0 + go * 768); if (has1) kr1 = *(const u32x4*)(kg1 + go * 768); vr = *(const u32x4*)(vg + go * 512); }
        const ATT_LAS unsigned char* Kt = lds + cur * KT; const ATT_LAS unsigned char* Vt = lds + OFF_V + cur * VT;
        f32x16 p0 = {}, p1 = {};
#pragma unroll
        for (int s = 0; s < 6; ++s) {
            const bf16x8 a0 = *(const ATT_LAS bf16x8*)(Kt + r * KP + (16 * s + 8 * hi) * 2);
            const bf16x8 a1 = *(const ATT_LAS bf16x8*)(Kt + (r + 32) * KP + (16 * s + 8 * hi) * 2);
            p0 = ATT_MFMA(a0, qf[s], p0); p1 = ATT_MFMA(a1, qf[s], p1);
        }
        if (64 * t + 63 > q0 + wid * 32) {
            const float NEG = -__builtin_inff();
#pragma unroll
            for (int i = 0; i < 16; ++i) { const int key = 64 * t + crow(i, hi); if (key > qabs) p0[i] = NEG; if (key + 32 > qabs) p1[i] = NEG; }
        }
        float mx = fmaxf(p0[0], p1[0]);
#pragma unroll
        for (int i = 1; i < 16; ++i) mx = fmaxf(mx, fmaxf(p0[i], p1[i]));
        mx = fmaxf(mx, __shfl_xor(mx, 32));
        const float mn = fmaxf(m, mx); const float alpha = __builtin_amdgcn_exp2f(m - mn); m = mn;
        float sum = 0.f;
#pragma unroll
        for (int i = 0; i < 16; ++i) { p0[i] = __builtin_amdgcn_exp2f(p0[i] - mn); p1[i] = __builtin_amdgcn_exp2f(p1[i] - mn); sum += p0[i] + p1[i]; }
        l = l * alpha + sum;
        if (hi == 0) scr[r] = alpha;
#pragma unroll
        for (int i = 0; i < 16; ++i) { const float f = scr[crow(i, hi)]; o0[i] *= f; o1[i] *= f; }
#pragma unroll
        for (int s = 0; s < 4; ++s) {
            const bf16x8 pa = (s == 0) ? ATT_PACK(p0, 0) : (s == 1) ? ATT_PACK(p0, 8) : (s == 2) ? ATT_PACK(p1, 0) : ATT_PACK(p1, 8);
            const ATT_LAS unsigned char* vp = Vt + vrd + (16 * s) * VP;
            const s16x4 l0 = vtr(vp), h0 = vtr(vp + 8 * VP), l1 = vtr(vp + 64), h1 = vtr(vp + 8 * VP + 64);
            const bf16x8 v0 = {l0[0], l0[1], l0[2], l0[3], h0[0], h0[1], h0[2], h0[3]}, v1 = {l1[0], l1[1], l1[2], l1[3], h1[0], h1[1], h1[2], h1[3]};
            o0 = ATT_MFMA(pa, v0, o0); o1 = ATT_MFMA(pa, v1, o1);
        }
        if (t + 1 < NT) { ATT_LAS unsigned char* nb = lds + (cur ^ 1) * KT; *(ATT_LAS u32x4*)(nb + kd0) = kr0; if (has1) *(ATT_LAS u32x4*)(nb + kd1) = kr1; *(ATT_LAS u32x4*)(lds + OFF_V + (cur ^ 1) * VT + vd) = vr; }
        __syncthreads();
    }
    l += __shfl_xor(l, 32);
    if (hi == 0) scr[r] = 1.0f / l;
    bf16_t* op = cat + (rowbase + q0 + wid * 32) * 1024 + 512 + h * 64 + r;
#pragma unroll
    for (int i = 0; i < 16; ++i) { const int row = crow(i, hi); const float f = scr[row];
        const unsigned w0 = cvtpk(o0[i] * f, 0.f), w1 = cvtpk(o1[i] * f, 0.f);
        op[(size_t)row * 1024] = (bf16_t)(w0 & 0xffffu); op[(size_t)row * 1024 + 32] = (bf16_t)(w1 & 0xffffu); }
    __syncthreads();
}
#undef ATT_MFMA
#undef ATT_PACK
}
namespace rw {
#define RW_LAS __attribute__((address_space(3)))
typedef unsigned short bf16_t;
typedef short bf16x8 __attribute__((ext_vector_type(8)));
typedef float f32x16 __attribute__((ext_vector_type(16)));
typedef float f32x4 __attribute__((ext_vector_type(4)));
typedef unsigned u32x2 __attribute__((ext_vector_type(2)));
typedef unsigned u32x4 __attribute__((ext_vector_type(4)));
typedef float f32x2 __attribute__((ext_vector_type(2))); typedef __bf16 bf16x2_t __attribute__((ext_vector_type(2)));
__device__ __forceinline__ unsigned cvtpk(float lo, float hi) { f32x2 v = {lo, hi}; bf16x2_t b = __builtin_convertvector(v, bf16x2_t); return __builtin_bit_cast(unsigned, b); }
__device__ __forceinline__ unsigned short f2b(float x) { return (unsigned short)(cvtpk(x, 0.f) & 0xffffu); }
__device__ __forceinline__ float b2f(unsigned short b) { return __uint_as_float((unsigned)b << 16); }
__device__ __forceinline__ int crow(int r, int hi) { return (r & 3) + 8 * (r >> 2) + 4 * hi; }
#define RW_MFMA(a, b, c) __builtin_amdgcn_mfma_f32_32x32x16_bf16((a), (b), (c), 0, 0, 0)
constexpr int P = 72;
constexpr int PF = 68;
constexpr int MAT = 64 * P * 2;
constexpr int L_AT_TK = 0 * MAT, L_AT_KT = 1 * MAT, L_BT_TK = 2 * MAT, L_KT_TK = 3 * MAT, L_RT_TK = 4 * MAT, L_BH_KT = 5 * MAT, L_KH_KT = 6 * MAT, L_V_VT = 7 * MAT;
constexpr int L_LAK = 8 * MAT, L_PRB = 9 * MAT, L_PRK = 10 * MAT, L_MI = 11 * MAT, L_X1 = 12 * MAT, L_W = 13 * MAT, L_U0 = 14 * MAT;
constexpr int L_M11ST = 15 * MAT, L_Z1ST = 15 * MAT + 4608, L_L21 = 16 * MAT;
constexpr int L_TOT = 16 * MAT + 4608;
constexpr int L_GC = L_TOT + 2048;
constexpr int L_END = L_GC + 256;
constexpr int L_XW = 0, L_XA = MAT, L_XG = 2 * MAT;
constexpr int PG = 136;
constexpr int L_DW = 8 * MAT, L_DA = 8 * MAT + 64 * PF * 4, L_GT = 8 * MAT + 2 * 64 * PF * 4;
static_assert(L_GT + 64 * PF * 4 <= 15 * MAT, "lora scratch overlay");
constexpr int R_T = 0, R_G = 8192, R_QM = 24576, R_Y0 = 32768, R_G1 = 40960, R_G2 = 49152, R_H = 57344, R_BYTES = 65536;

__device__ __forceinline__ bf16x8 ldfrag(const RW_LAS unsigned char* mat, int row, int kofs) { return *(const RW_LAS bf16x8*)(mat + (row * P + kofs) * 2); }
__device__ __forceinline__ void st_tile(const f32x16& a, RW_LAS unsigned char* mat, int lanerow, int R0, int hi) {
#pragma unroll
    for (int g = 0; g < 4; ++g) *(RW_LAS u32x2*)(mat + (lanerow * P + R0 + 8 * g + 4 * hi) * 2) = (u32x2){cvtpk(a[4 * g], a[4 * g + 1]), cvtpk(a[4 * g + 2], a[4 * g + 3])};
}
__device__ __forceinline__ void st_tile_f32(const f32x16& a, RW_LAS unsigned char* mat, int lanerow, int R0, int hi) {
#pragma unroll
    for (int g = 0; g < 4; ++g) *(RW_LAS f32x4*)(mat + (lanerow * PF + R0 + 8 * g + 4 * hi) * 4) = (f32x4){a[4 * g], a[4 * g + 1], a[4 * g + 2], a[4 * g + 3]};
}
__device__ __forceinline__ bf16x8 pack8(const f32x16& x, int s) { u32x4 p = {cvtpk(x[8 * s], x[8 * s + 1]), cvtpk(x[8 * s + 2], x[8 * s + 3]), cvtpk(x[8 * s + 4], x[8 * s + 5]), cvtpk(x[8 * s + 6], x[8 * s + 7])}; return __builtin_bit_cast(bf16x8, p); }
template <int KS> __device__ __forceinline__ f32x16 mm(const RW_LAS unsigned char* A, int a0, const RW_LAS unsigned char* B, int b0, int k0, int r, int hi, f32x16 acc) {
#pragma unroll
    for (int s = 0; s < KS; ++s) acc = RW_MFMA(ldfrag(A, a0 + r, k0 + 16 * s + 8 * hi), ldfrag(B, b0 + r, k0 + 16 * s + 8 * hi), acc);
    return acc;
}
__device__ __forceinline__ float wsum(float v) {
#pragma unroll
    for (int o = 1; o < 64; o <<= 1) v += __shfl_xor(v, o);
    return v;
}
constexpr int CT_STRIDE = 12, CT_MUX = 512 * CT_STRIDE;
struct R1Params { const bf16_t* HB; const float* CT; const bf16_t* W2t; unsigned char* REC; };
__device__ __forceinline__ void r1_unit(const R1Params& p, int b, int h, int c, RW_LAS unsigned char* lds, const int tid) {
    const int lane = tid & 63, r = lane & 31, hi = lane >> 5; const int w = tid >> 6;
    const size_t tok0 = (size_t)b * 4096 + (size_t)c * 64;
    unsigned char* rec = p.REC + ((size_t)((b * 8 + h) * 64 + c)) * R_BYTES;
    {
        const bf16_t* hp = p.HB + (tok0 + 8 * w) * 2560;
        float pw, pa, pg0, pg1;
        const bool first = (c == 0 && w == 0);
        if (first) { pw = pa = pg0 = pg1 = 0.f; } else { pw = b2f(hp[-2560 + 1536 + lane]); pa = b2f(hp[-2560 + 1600 + lane]); pg0 = b2f(hp[-2560 + 1664 + lane]); pg1 = b2f(hp[-2560 + 1728 + lane]); }
        const float mw = p.CT[CT_MUX + lane], ma = p.CT[CT_MUX + 64 + lane], mg0 = p.CT[CT_MUX + 128 + lane], mg1 = p.CT[CT_MUX + 192 + lane];
#pragma unroll
        for (int i = 0; i < 8; ++i) {
            const int t = 8 * w + i;
            const float cw = b2f(hp[i * 2560 + 1536 + lane]), ca = b2f(hp[i * 2560 + 1600 + lane]), cg0 = b2f(hp[i * 2560 + 1664 + lane]), cg1 = b2f(hp[i * 2560 + 1728 + lane]);
            const float xw = cw + (pw - cw) * mw, xa = ca + (pa - ca) * ma, xg0 = cg0 + (pg0 - cg0) * mg0, xg1 = cg1 + (pg1 - cg1) * mg1;
            pw = cw; pa = ca; pg0 = cg0; pg1 = cg1;
            *(RW_LAS unsigned short*)(lds + L_XW + (t * P + lane) * 2) = f2b(tanhf(xw));
            *(RW_LAS unsigned short*)(lds + L_XA + (t * P + lane) * 2) = f2b(xa);
            *(RW_LAS unsigned short*)(lds + L_XG + (t * PG + lane) * 2) = f2b(1.f / (1.f + __expf(-xg0)));
            *(RW_LAS unsigned short*)(lds + L_XG + (t * PG + 64 + lane) * 2) = f2b(1.f / (1.f + __expf(-xg1)));
        }
    }
    __syncthreads();
    {
#pragma unroll
        for (int jj = 0; jj < 2; ++jj) {
            const int job = w + 8 * jj;
            if (job < 12) {
                const int mat = job >> 2, ct = (job >> 1) & 1, tt = job & 1;
                f32x16 acc = {};
                if (mat < 2) {
                    const bf16_t* wt = p.W2t + (mat == 0 ? 0 : 512 * 64) + (size_t)(h * 64 + 32 * ct + r) * 64;
                    const RW_LAS unsigned char* xin = lds + (mat == 0 ? L_XW : L_XA);
#pragma unroll
                    for (int s = 0; s < 4; ++s) acc = RW_MFMA(*(const bf16x8*)(wt + 16 * s + 8 * hi), ldfrag(xin, 32 * tt + r, 16 * s + 8 * hi), acc);
                } else {
                    const bf16_t* wt = p.W2t + 2 * 512 * 64 + (size_t)(h * 64 + 32 * ct + r) * 128;
#pragma unroll
                    for (int s = 0; s < 8; ++s) acc = RW_MFMA(*(const bf16x8*)(wt + 16 * s + 8 * hi), *(const RW_LAS bf16x8*)(lds + L_XG + ((32 * tt + r) * PG + 16 * s + 8 * hi) * 2), acc);
                }
                st_tile_f32(acc, lds + (mat == 0 ? L_DW : mat == 1 ? L_DA : L_GT), 32 * tt + r, 32 * ct, hi);
            }
        }
    }
    __syncthreads();
    {
        const int ch = lane;
        const bf16_t* hp = p.HB + (tok0 + 8 * w) * 2560 + h * 64 + ch;
        float pr, pk, pv;
        if (c == 0 && w == 0) { pr = pk = pv = 0.f; } else { pr = b2f(hp[-2560]); pk = b2f(hp[-2560 + 512]); pv = b2f(hp[-2560 + 1024]); }
        const int col = h * 64 + ch;
        const f32x4 c0 = *(const f32x4*)(p.CT + col * CT_STRIDE), c1 = *(const f32x4*)(p.CT + col * CT_STRIDE + 4), c2 = *(const f32x4*)(p.CT + col * CT_STRIDE + 8);
        const float mr = c0[0], mk = c0[1], mv = c0[2], w0 = c0[3], a0 = c1[0], kkc = c1[1], kac = c1[2], rkc = c1[3], lg = c2[0], lb = c2[1];
        float rr[8], k2[8], vv[8], kk[8], aa[8], lw[8], gg[8], bon[8];
#pragma unroll
        for (int i = 0; i < 8; ++i) {
            const int t = 8 * w + i;
            const float cr = b2f(hp[i * 2560]), ck = b2f(hp[i * 2560 + 512]), cv = b2f(hp[i * 2560 + 1024]);
            rr[i] = cr + (pr - cr) * mr; const float kx = ck + (pk - ck) * mk; vv[i] = cv + (pv - cv) * mv; pr = cr; pk = ck; pv = cv;
            const float dw = *(const RW_LAS float*)(lds + L_DW + (t * PF + ch) * 4), da = *(const RW_LAS float*)(lds + L_DA + (t * PF + ch) * 4);
            gg[i] = *(const RW_LAS float*)(lds + L_GT + (t * PF + ch) * 4);
            const float z = -(w0 + dw); const float sp = (z > 20.f) ? z : __logf(1.f + __expf(z));
            lw[i] = -__expf(-sp - 0.5f);
            aa[i] = 1.f / (1.f + __expf(-(a0 + da)));
            const float kr = kx * kkc; const float ss = wsum(kr * kr); kk[i] = kr / fmaxf(sqrtf(ss), 1e-12f);
            k2[i] = kx * (1.f + (aa[i] - 1.f) * kac);
            bon[i] = wsum(rr[i] * k2[i] * rkc);
        }
        float cum[8]; cum[0] = lw[0];
#pragma unroll
        for (int i = 1; i < 8; ++i) cum[i] = cum[i - 1] + lw[i];
        *(RW_LAS float*)(lds + L_TOT + (w * 64 + ch) * 4) = cum[7];
        __syncthreads();
        float off = 0.f, tot = 0.f;
#pragma unroll
        for (int j = 0; j < 8; ++j) { const float v = *(const RW_LAS float*)(lds + L_TOT + (j * 64 + ch) * 4); tot += v; if (j < w) off += v; }
        if (w == 0) *(RW_LAS float*)(lds + L_GC + ch * 4) = __expf(tot);
        unsigned atk[4], bhk[4], khk[4], vvt[4];
        bf16_t* g1p = (bf16_t*)(rec + R_G1); bf16_t* g2p = (bf16_t*)(rec + R_G2);
#pragma unroll
        for (int i = 0; i < 8; ++i) {
            const int t = 8 * w + i;
            const float cn = off + cum[i], cp = cn - lw[i];
            const float ecp = __expf(cp), ecn = __expf(-cn), ec = __expf(cn), ech = __expf(tot - cn);
            const float at = -kk[i] * ecp, bt = kk[i] * aa[i] * ecn, kt = k2[i] * ecn, rt = rr[i] * ec, bh = kk[i] * aa[i] * ech, kh = k2[i] * ech;
            *(RW_LAS unsigned short*)(lds + L_AT_TK + (t * P + ch) * 2) = f2b(at);
            *(RW_LAS unsigned short*)(lds + L_BT_TK + (t * P + ch) * 2) = f2b(bt);
            *(RW_LAS unsigned short*)(lds + L_KT_TK + (t * P + ch) * 2) = f2b(kt);
            *(RW_LAS unsigned short*)(lds + L_RT_TK + (t * P + ch) * 2) = f2b(rt);
            const unsigned sh = (i & 1) * 16;
            if ((i & 1) == 0) { atk[i >> 1] = 0u; bhk[i >> 1] = 0u; khk[i >> 1] = 0u; vvt[i >> 1] = 0u; }
            atk[i >> 1] |= (unsigned)f2b(at) << sh; bhk[i >> 1] |= (unsigned)f2b(bh) << sh; khk[i >> 1] |= (unsigned)f2b(kh) << sh; vvt[i >> 1] |= (unsigned)f2b(vv[i]) << sh;
            g1p[t * 64 + ch] = f2b(gg[i] * lg);
            g2p[t * 64 + ch] = f2b((lb + bon[i] * vv[i]) * gg[i]);
        }
        *(RW_LAS u32x4*)(lds + L_AT_KT + (ch * P + 8 * w) * 2) = (u32x4){atk[0], atk[1], atk[2], atk[3]};
        *(RW_LAS u32x4*)(lds + L_BH_KT + (ch * P + 8 * w) * 2) = (u32x4){bhk[0], bhk[1], bhk[2], bhk[3]};
        *(RW_LAS u32x4*)(lds + L_KH_KT + (ch * P + 8 * w) * 2) = (u32x4){khk[0], khk[1], khk[2], khk[3]};
        *(RW_LAS u32x4*)(lds + L_V_VT + (ch * P + 8 * w) * 2) = (u32x4){vvt[0], vvt[1], vvt[2], vvt[3]};
    }
    __syncthreads();
    {
        const RW_LAS unsigned char* AT = lds + L_AT_TK; const RW_LAS unsigned char* BT = lds + L_BT_TK; const RW_LAS unsigned char* KT = lds + L_KT_TK; const RW_LAS unsigned char* RT = lds + L_RT_TK;
        if (w < 2) {
            const int o = 32 * w; f32x16 z = {};
            f32x16 XA = mm<4>(AT, o, BT, o, 0, r, hi, z);
            f32x16 XTA = mm<4>(BT, o, AT, o, 0, r, hi, z);
#pragma unroll
            for (int i = 0; i < 16; ++i) { const int rw_ = crow(i, hi); if (!(rw_ > r)) XA[i] = 0.f; if (!(r > rw_)) XTA[i] = 0.f; }
            f32x16 PA = XA, PTA = XTA;
#pragma unroll
            for (int i = 0; i < 16; ++i) { if (crow(i, hi) == r) { PA[i] += 1.f; PTA[i] += 1.f; } }
#pragma unroll
            for (int it = 0; it < 4; ++it) {
                const bf16x8 xa0 = pack8(XA, 0), xa1 = pack8(XA, 1), xt0 = pack8(XTA, 0), xt1 = pack8(XTA, 1);
                f32x16 nXA = RW_MFMA(xt0, xa0, z); nXA = RW_MFMA(xt1, xa1, nXA);
                f32x16 nXT = RW_MFMA(xa0, xt0, z); nXT = RW_MFMA(xa1, xt1, nXT);
                XA = nXA; XTA = nXT;
                const bf16x8 na0 = pack8(XA, 0), na1 = pack8(XA, 1), nt0 = pack8(XTA, 0), nt1 = pack8(XTA, 1);
                const bf16x8 pt0 = pack8(PTA, 0), pt1 = pack8(PTA, 1), pa0 = pack8(PA, 0), pa1 = pack8(PA, 1);
                PA = RW_MFMA(pt0, na0, PA); PA = RW_MFMA(pt1, na1, PA);
                PTA = RW_MFMA(na0, pt0, PTA); PTA = RW_MFMA(na1, pt1, PTA);
                (void)nt0; (void)nt1; (void)pa0; (void)pa1;
            }
            st_tile(PTA, lds + L_MI, o + r, o, hi);
            if (w == 0) {
                st_tile(PA, lds + L_M11ST, r, 0, hi);
#pragma unroll
                for (int g = 0; g < 4; ++g) *(RW_LAS u32x2*)(lds + L_MI + (r * P + 32 + 8 * g + 4 * hi) * 2) = (u32x2){0u, 0u};
            }
        } else {
            for (int job = w - 2; job < 10; job += 6) {
                f32x16 z = {};
                if (job == 9) { const f32x16 acc = mm<4>(BT, 0, AT, 32, 0, r, hi, z); st_tile(acc, lds + L_L21, r, 0, hi); }
                else {
                    const int mat = job / 3, q = job % 3, tt = (q == 0) ? 0 : 1, st = (q == 2) ? 1 : 0;
                    const RW_LAS unsigned char* Y = (mat == 1) ? BT : KT; const RW_LAS unsigned char* X = (mat == 0) ? AT : RT;
                    f32x16 acc = mm<4>(Y, 32 * st, X, 32 * tt, 0, r, hi, z);
                    if (tt == st) {
#pragma unroll
                        for (int i = 0; i < 16; ++i) { const int s_ = crow(i, hi); const bool keep = (mat == 0) ? (r > s_) : (r >= s_); if (!keep) acc[i] = 0.f; }
                    }
                    RW_LAS unsigned char* dst = lds + (mat == 0 ? L_LAK : mat == 1 ? L_PRB : L_PRK);
                    st_tile(acc, dst, 32 * tt + r, 32 * st, hi);
                    if (q == 0) {
#pragma unroll
                        for (int g = 0; g < 4; ++g) *(RW_LAS u32x2*)(dst + (r * P + 32 + 8 * g + 4 * hi) * 2) = (u32x2){0u, 0u};
                    }
                }
            }
        }
    }
    __syncthreads();
    if (w == 0) {
        f32x16 z = {};
        const f32x16 acc = mm<2>(lds + L_L21, 0, lds + L_M11ST, 0, 0, r, hi, z);
        st_tile(acc, lds + L_Z1ST, r, 0, hi);
    } else if (w >= 2 && w < 6) {
        const int tt = (w - 2) >> 1, vt = (w - 2) & 1; f32x16 z = {};
        const f32x16 acc = (tt == 0) ? mm<2>(lds + L_LAK, 0, lds + L_V_VT, 32 * vt, 0, r, hi, z) : mm<4>(lds + L_LAK, 32, lds + L_V_VT, 32 * vt, 0, r, hi, z);
        st_tile(acc, lds + L_X1, 32 * vt + r, 32 * tt, hi);
    }
    __syncthreads();
    if (w == 0) {
        f32x16 z = {};
        f32x16 acc = z;
#pragma unroll
        for (int s = 0; s < 2; ++s) acc = RW_MFMA(ldfrag(lds + L_Z1ST, r, 16 * s + 8 * hi), *(const RW_LAS bf16x8*)(lds + L_MI + ((32 + r) * P + 32 + 16 * s + 8 * hi) * 2), acc);
        st_tile(acc, lds + L_MI, 32 + r, 0, hi);
    }
    __syncthreads();
    {
        const int mat = w >> 2, tt = (w >> 1) & 1, ct = w & 1; f32x16 z = {};
        const RW_LAS unsigned char* B = lds + (mat == 0 ? L_AT_KT : L_X1);
        const f32x16 acc = (tt == 0) ? mm<2>(lds + L_MI, 0, B, 32 * ct, 0, r, hi, z) : mm<4>(lds + L_MI, 32, B, 32 * ct, 0, r, hi, z);
        st_tile(acc, lds + (mat == 0 ? L_W : L_U0), 32 * ct + r, 32 * tt, hi);
    }
    __syncthreads();
    {
#pragma unroll
        for (int jj = 0; jj < 2; ++jj) {
            const int job = w + 8 * jj; const int mat = job >> 2, at = (job >> 1) & 1, bt = job & 1; f32x16 z = {};
            if (mat == 0) {
                f32x16 acc = mm<4>(lds + L_W, 32 * at, lds + L_BH_KT, 32 * bt, 0, r, hi, z);
                if (at == bt) { const float gc = *(const RW_LAS float*)(lds + L_GC + (32 * bt + r) * 4);
#pragma unroll
                    for (int i = 0; i < 16; ++i) if (crow(i, hi) == r) acc[i] += gc; }
                bf16_t* dst = (bf16_t*)(rec + R_T) + (32 * bt + r) * 64 + 32 * at;
#pragma unroll
                for (int g = 0; g < 4; ++g) *(u32x2*)(dst + 8 * g + 4 * hi) = (u32x2){cvtpk(acc[4 * g], acc[4 * g + 1]), cvtpk(acc[4 * g + 2], acc[4 * g + 3])};
            } else if (mat == 1) {
                f32x16 acc = mm<4>(lds + L_BH_KT, 32 * at, lds + L_U0, 32 * bt, 0, r, hi, z);
                acc = mm<4>(lds + L_KH_KT, 32 * at, lds + L_V_VT, 32 * bt, 0, r, hi, acc);
                float* dst = (float*)(rec + R_G) + (32 * bt + r) * 64 + 32 * at;
#pragma unroll
                for (int g = 0; g < 4; ++g) *(f32x4*)(dst + 8 * g + 4 * hi) = (f32x4){acc[4 * g], acc[4 * g + 1], acc[4 * g + 2], acc[4 * g + 3]};
            } else if (mat == 2) {
                f32x16 acc = (bt == 0) ? mm<2>(lds + L_W, 32 * at, lds + L_PRB, 0, 0, r, hi, z) : mm<4>(lds + L_W, 32 * at, lds + L_PRB, 32, 0, r, hi, z);
                bf16_t* dst = (bf16_t*)(rec + R_QM) + (32 * bt + r) * 64 + 32 * at;
#pragma unroll
                for (int g = 0; g < 4; ++g) { const u32x2 rt = *(const RW_LAS u32x2*)(lds + L_RT_TK + ((32 * bt + r) * P + 32 * at + 8 * g + 4 * hi) * 2);
                    const float r0 = __uint_as_float(rt.x << 16), r1 = __uint_as_float(rt.x & 0xffff0000u), r2 = __uint_as_float(rt.y << 16), r3 = __uint_as_float(rt.y & 0xffff0000u);
                    *(u32x2*)(dst + 8 * g + 4 * hi) = (u32x2){cvtpk(acc[4 * g] + r0, acc[4 * g + 1] + r1), cvtpk(acc[4 * g + 2] + r2, acc[4 * g + 3] + r3)}; }
            } else {
                f32x16 acc = (bt == 0) ? mm<2>(lds + L_U0, 32 * at, lds + L_PRB, 0, 0, r, hi, z) : mm<4>(lds + L_U0, 32 * at, lds + L_PRB, 32, 0, r, hi, z);
                acc = (bt == 0) ? mm<2>(lds + L_V_VT, 32 * at, lds + L_PRK, 0, 0, r, hi, acc) : mm<4>(lds + L_V_VT, 32 * at, lds + L_PRK, 32, 0, r, hi, acc);
                bf16_t* dst = (bf16_t*)(rec + R_Y0) + (32 * bt + r) * 64 + 32 * at;
#pragma unroll
                for (int g = 0; g < 4; ++g) *(u32x2*)(dst + 8 * g + 4 * hi) = (u32x2){cvtpk(acc[4 * g], acc[4 * g + 1]), cvtpk(acc[4 * g + 2], acc[4 * g + 3])};
            }
        }
    }
    __syncthreads();
}

__device__ __forceinline__ void r2_task(unsigned char* REC, int bh, int vh, int lane) {
    const int r = lane & 31, hi = lane >> 5;
    f32x16 H0 = {}, H1 = {};
    for (int c = 0; c < 64; ++c) {
        unsigned char* rec = REC + ((size_t)(bh * 64 + c)) * R_BYTES;
        const bf16_t* Tm = (const bf16_t*)(rec + R_T); const float* Gm = (const float*)(rec + R_G) + (32 * vh + r) * 64; bf16_t* Hm = (bf16_t*)(rec + R_H) + (32 * vh + r) * 64;
#pragma unroll
        for (int g = 0; g < 4; ++g) { *(u32x2*)(Hm + 8 * g + 4 * hi) = (u32x2){cvtpk(H0[4 * g], H0[4 * g + 1]), cvtpk(H0[4 * g + 2], H0[4 * g + 3])};
                                      *(u32x2*)(Hm + 32 + 8 * g + 4 * hi) = (u32x2){cvtpk(H1[4 * g], H1[4 * g + 1]), cvtpk(H1[4 * g + 2], H1[4 * g + 3])}; }
        f32x16 N0, N1;
#pragma unroll
        for (int g = 0; g < 4; ++g) { const f32x4 a = *(const f32x4*)(Gm + 8 * g + 4 * hi), b = *(const f32x4*)(Gm + 32 + 8 * g + 4 * hi);
            N0[4 * g] = a[0]; N0[4 * g + 1] = a[1]; N0[4 * g + 2] = a[2]; N0[4 * g + 3] = a[3]; N1[4 * g] = b[0]; N1[4 * g + 1] = b[1]; N1[4 * g + 2] = b[2]; N1[4 * g + 3] = b[3]; }
        const bf16x8 h00 = pack8(H0, 0), h01 = pack8(H0, 1), h10 = pack8(H1, 0), h11 = pack8(H1, 1);
#pragma unroll
        for (int kt = 0; kt < 2; ++kt) {
            const bf16_t* tr = Tm + (32 * kt + r) * 64;
            f32x16 acc = kt == 0 ? N0 : N1;
#pragma unroll
            for (int j = 0; j < 2; ++j)
#pragma unroll
                for (int s = 0; s < 2; ++s) {
                    const u32x2 lo = *(const u32x2*)(tr + 32 * j + 16 * s + 4 * hi), hi2 = *(const u32x2*)(tr + 32 * j + 16 * s + 8 + 4 * hi);
                    const bf16x8 a = __builtin_bit_cast(bf16x8, (u32x4){lo.x, lo.y, hi2.x, hi2.y});
                    acc = RW_MFMA(a, (j == 0 ? (s == 0 ? h00 : h01) : (s == 0 ? h10 : h11)), acc);
                }
            if (kt == 0) N0 = acc; else N1 = acc;
        }
        H0 = N0; H1 = N1;
    }
}

__device__ __forceinline__ void r3_task(const unsigned char* REC, bf16_t* CAT, int ch_id, int tt, int lane) {
    const int r = lane & 31, hi = lane >> 5;
    const unsigned char* rec = REC + (size_t)ch_id * R_BYTES;
    const int bh = ch_id >> 6, c = ch_id & 63, b = bh >> 3, h = bh & 7;
    const bf16_t* Hm = (const bf16_t*)(rec + R_H); const bf16_t* Qm = (const bf16_t*)(rec + R_QM) + (32 * tt + r) * 64;
    f32x16 y0 = {}, y1 = {};
#pragma unroll
    for (int s = 0; s < 4; ++s) {
        const bf16x8 q = *(const bf16x8*)(Qm + 16 * s + 8 * hi);
        y0 = RW_MFMA(*(const bf16x8*)(Hm + r * 64 + 16 * s + 8 * hi), q, y0);
        y1 = RW_MFMA(*(const bf16x8*)(Hm + (32 + r) * 64 + 16 * s + 8 * hi), q, y1);
    }
    const bf16_t* Y0 = (const bf16_t*)(rec + R_Y0) + (32 * tt + r) * 64; const bf16_t* G1 = (const bf16_t*)(rec + R_G1) + (32 * tt + r) * 64; const bf16_t* G2 = (const bf16_t*)(rec + R_G2) + (32 * tt + r) * 64;
    float sum = 0.f;
#pragma unroll
    for (int g = 0; g < 4; ++g) {
        const u32x2 a = *(const u32x2*)(Y0 + 8 * g + 4 * hi), b2 = *(const u32x2*)(Y0 + 32 + 8 * g + 4 * hi);
        y0[4 * g] += __uint_as_float(a.x << 16); y0[4 * g + 1] += __uint_as_float(a.x & 0xffff0000u); y0[4 * g + 2] += __uint_as_float(a.y << 16); y0[4 * g + 3] += __uint_as_float(a.y & 0xffff0000u);
        y1[4 * g] += __uint_as_float(b2.x << 16); y1[4 * g + 1] += __uint_as_float(b2.x & 0xffff0000u); y1[4 * g + 2] += __uint_as_float(b2.y << 16); y1[4 * g + 3] += __uint_as_float(b2.y & 0xffff0000u);
    }
#pragma unroll
    for (int i = 0; i < 16; ++i) sum += y0[i] + y1[i];
    sum += __shfl_xor(sum, 32);
    const float mean = sum * (1.f / 64.f); float sq = 0.f;
#pragma unroll
    for (int i = 0; i < 16; ++i) { y0[i] -= mean; y1[i] -= mean; sq += y0[i] * y0[i] + y1[i] * y1[i]; }
    sq += __shfl_xor(sq, 32);
    const float rstd = 1.0f / sqrtf(sq * (1.f / 64.f) + 64e-5f);
    bf16_t* op = CAT + ((size_t)b * 4096 + (size_t)c * 64 + 32 * tt + r) * 1024 + h * 64;
#pragma unroll
    for (int g = 0; g < 4; ++g) {
#pragma unroll
        for (int half = 0; half < 2; ++half) {
            const int vo = 32 * half + 8 * g + 4 * hi;
            const u32x2 a = *(const u32x2*)(G1 + vo), b2 = *(const u32x2*)(G2 + vo);
            const f32x16& y = half == 0 ? y0 : y1;
            const float o0 = y[4 * g] * rstd * __uint_as_float(a.x << 16) + __uint_as_float(b2.x << 16), o1 = y[4 * g + 1] * rstd * __uint_as_float(a.x & 0xffff0000u) + __uint_as_float(b2.x & 0xffff0000u);
            const float o2 = y[4 * g + 2] * rstd * __uint_as_float(a.y << 16) + __uint_as_float(b2.y << 16), o3 = y[4 * g + 3] * rstd * __uint_as_float(a.y & 0xffff0000u) + __uint_as_float(b2.y & 0xffff0000u);
            *(u32x2*)(op + vo) = (u32x2){cvtpk(o0, o1), cvtpk(o2, o3)};
        }
    }
}
#undef RW_MFMA
}
#define GAS __attribute__((address_space(1)))
#define LAS __attribute__((address_space(3)))
typedef unsigned short bf16;
typedef unsigned v4u __attribute__((ext_vector_type(4)));
typedef float f32x4 __attribute__((ext_vector_type(4)));
typedef short bf16x8 __attribute__((ext_vector_type(8)));
typedef GAS unsigned gu32;
typedef GAS unsigned long long gu64;
#define RLX_AGENT __ATOMIC_RELAXED, __HIP_MEMORY_SCOPE_AGENT
#define LDS_WAIT() asm volatile("s_waitcnt lgkmcnt(0)" ::: "memory")
#define VM_WAIT() asm volatile("s_waitcnt vmcnt(0)" ::: "memory")
__device__ __forceinline__ unsigned long long rt() { return __builtin_amdgcn_s_memrealtime(); }
__device__ __forceinline__ unsigned f2bf(float f) { unsigned u = __builtin_bit_cast(unsigned, f); return (u + 0x7fffu + ((u >> 16) & 1u)) >> 16; }
__device__ __forceinline__ unsigned pk2(float lo, float hi) { return f2bf(lo) | (f2bf(hi) << 16); }

#define XB_TMO      128
#define XB_XCNT(j)  (256  + 64 * (j))
#define XB_XSUB(j)  (1280 + 64 * (j))
#define XB_XGEN(j)  (2304 + 64 * (j))
#define XB_TOP      3328
#define XB_TOPGEN   3392
#define XCD_BAR_WORDS 3456
#define XB_SPIN_CAP (1u << 18)

__device__ __forceinline__ unsigned xb_ld(unsigned* p)              { return __hip_atomic_load(p, __ATOMIC_RELAXED, __HIP_MEMORY_SCOPE_AGENT); }
__device__ __forceinline__ unsigned xb_add(unsigned* p, unsigned v) { return __hip_atomic_fetch_add(p, v, __ATOMIC_RELAXED, __HIP_MEMORY_SCOPE_AGENT); }
__device__ __forceinline__ unsigned xb_xcc_id() { return (unsigned)__builtin_amdgcn_s_getreg((3 << 11) | 20) & 0xFu; }
#define XB_SPIN(cond, bar) do { unsigned _sp = 0; while (cond) { __builtin_amdgcn_s_sleep(1); \
    if ((++_sp & 255u) == 0u) { if (xb_ld(&(bar)[XB_TMO])) break; if (_sp > XB_SPIN_CAP) { atomicAdd(&(bar)[XB_TMO], 1u); break; } } } } while (0)

struct XcdBarrier {
    unsigned* bar; unsigned x;
    volatile LAS unsigned* st;
};

__device__ __forceinline__ XcdBarrier xcd_barrier_post(unsigned* bar, volatile LAS unsigned* st, bool is_t0) {
    XcdBarrier b; b.bar = bar; b.x = xb_xcc_id(); b.st = st;
    if (is_t0) (void)xb_add(&bar[XB_XCNT(b.x)], 1u);
    return b;
}
__device__ __forceinline__ void xcd_barrier_complete(unsigned* bar, unsigned x, unsigned& nloc, unsigned& nx) {
    const unsigned G = gridDim.x * gridDim.y * gridDim.z;
    unsigned sum, cnt, mine, sp = 0u;
    for (;;) {
        sum = 0u; cnt = 0u; mine = 0u;
#pragma unroll
        for (unsigned j = 0; j < 16; ++j) { const unsigned c = xb_ld(&bar[XB_XCNT(j)]); sum += c; cnt += (c > 0u) ? 1u : 0u; mine = (j == x) ? c : mine; }
        if (sum == G) break;
        __builtin_amdgcn_s_sleep(1);
        if ((++sp & 255u) == 0u) { if (xb_ld(&bar[XB_TMO])) break; if (sp > XB_SPIN_CAP) { atomicAdd(&bar[XB_TMO], 1u); break; } }
    }
    nloc = mine > 0u ? mine : 1u; nx = cnt > 0u ? cnt : 1u;
}

__device__ __forceinline__ void xcd_barrier(const XcdBarrier& b, bool is_t0) {
    asm volatile("s_waitcnt vmcnt(0)" ::: "memory");
    __syncthreads();
    if (is_t0) {
        unsigned* bar = b.bar;
        __builtin_amdgcn_s_waitcnt(0);
        unsigned nloc = b.st[0], nx = b.st[1];
        if (nloc == 0u) { xcd_barrier_complete(bar, b.x, nloc, nx); b.st[0] = nloc; b.st[1] = nx; }
        const unsigned old = xb_add(&bar[XB_XSUB(b.x)], 1u);
        const unsigned gen = old / nloc;
        if (old + 1u == (gen + 1u) * nloc) {
            __builtin_amdgcn_fence(__ATOMIC_RELEASE, "agent");
            asm volatile("s_waitcnt vmcnt(0)" ::: "memory");
            const unsigned og = xb_add(&bar[XB_TOP], 1u);
            const unsigned tg = og / nx;
            if (og + 1u == (tg + 1u) * nx) xb_add(&bar[XB_TOPGEN], 1u);
            else XB_SPIN(xb_ld(&bar[XB_TOPGEN]) == tg, bar);
            __builtin_amdgcn_fence(__ATOMIC_ACQUIRE, "agent");
            xb_add(&bar[XB_XGEN(b.x)], 1u);
            asm volatile("s_waitcnt vmcnt(0)" ::: "memory");
        } else {
            XB_SPIN(xb_ld(&bar[XB_XGEN(b.x)]) == gen, bar);
            __builtin_amdgcn_fence(__ATOMIC_ACQUIRE, "agent");
            asm volatile("s_waitcnt vmcnt(0)" ::: "memory");
        }
    }
    __syncthreads();
}
constexpr int NWAVES = 8;
constexpr int BATCH = 8, SEQ = 4096, DM = 1024, M = BATCH * SEQ;
constexpr int IN_COLS = 2464, HP = 2560;
constexpr int RW_COLS = 1792, CQ_OFF = 1792, CKV_OFF = 2176, KPE_OFF = 2432;
constexpr int QL = 384, KVL = 256, NQ = 768, NKV = 1024, FF = 4096;
constexpr float ALPHA = 1.189207115002721f;
constexpr float LN_EPS = 1e-5f, RMS_EPS = 1e-6f, GN_EPS = 64e-5f;
constexpr float ATT_C2 = 0.10206207261596577f * 1.4426950408889634f;

constexpr size_t MiB = 1u << 20;
constexpr size_t WS_CTL = 0, CTL_ZERO_BYTES = 1 * MiB;
constexpr size_t WS_WIN = 1 * MiB;
constexpr size_t WS_WUQ = 6 * MiB;
constexpr size_t WS_WUKV = 7 * MiB;
constexpr size_t WS_WOUT = 8 * MiB;
constexpr size_t WS_WF1 = 10 * MiB;
constexpr size_t WS_WF2 = 18 * MiB;
constexpr size_t WS_W2T = 26 * MiB, WS_A2T = 26 * MiB + 65536, WS_G2T = 26 * MiB + 131072;
constexpr size_t WS_CT = 26 * MiB + 512 * 1024;
constexpr size_t WS_RSTDQ = 27 * MiB, WS_RSTDKV = 27 * MiB + 256 * 1024;
constexpr size_t WS_COS = 28 * MiB, WS_SIN = 30 * MiB;
constexpr size_t WS_XB = 32 * MiB;
constexpr size_t WS_CAT = 32 * MiB;
constexpr size_t WS_HB = 96 * MiB;
constexpr size_t WS_Q = 256 * MiB, WS_K = 304 * MiB, WS_V = 352 * MiB;
constexpr size_t WS_MIX = 96 * MiB;
constexpr size_t WS_X1B = 32 * MiB;
constexpr size_t WS_HID = 256 * MiB;
constexpr size_t WS_REC = 256 * MiB;
constexpr size_t WS_END = 512 * MiB;
constexpr int CW_TMO = 0, CW_CODE = 1, CW_BAR = 4096;

struct Frame {
    LAS unsigned char* lds;
    int wave;
    int vcu, G;
};
constexpr int RING_OFF = 0, RING_BYTES = 162816;
constexpr int LDSCTL_OFF = RING_BYTES, MISC_OFF = LDSCTL_OFF + 320;
constexpr int LDS_BYTES = 163840;
static_assert(rw::L_END <= RING_BYTES && att::LDS_BYTES <= RING_BYTES && pg8::STAGE_BYTES <= RING_BYTES, "LDS map");

__device__ __forceinline__ float wave_sum(float v) {
#pragma unroll
    for (int o = 1; o < 64; o <<= 1) v += __shfl_xor(v, o);
    return v;
}
__device__ __forceinline__ float bf2f(unsigned short b) { return __uint_as_float((unsigned)b << 16); }
template <class RowMap>
__device__ __forceinline__ void p0_transpose_item(const float* W, int K, int N, bf16* WT, const float* kscale, RowMap rm, LAS float* scr, int item, int lane, float cmul = 1.0f) {
    const int nblk = N / 32, kb = item / nblk, nb = item % nblk, k0 = 64 * kb, n0 = 32 * nb;
#pragma unroll 8
    for (int i = 0; i < 32; ++i) { const int kk = 2 * i + (lane >> 5); float v = W[(size_t)(k0 + kk) * N + n0 + (lane & 31)]; if (kscale) v *= kscale[k0 + kk] * cmul; scr[kk * 33 + (lane & 31)] = v; }
    LDS_WAIT(); asm volatile("" ::: "memory");
    const int c = lane & 7;
#pragma unroll
    for (int j = 0; j < 4; ++j) { const int n = (lane >> 3) + 8 * j; const LAS float* s = scr + (8 * c) * 33 + n;
        v4u o; o.x = pk2(s[0 * 33], s[1 * 33]); o.y = pk2(s[2 * 33], s[3 * 33]); o.z = pk2(s[4 * 33], s[5 * 33]); o.w = pk2(s[6 * 33], s[7 * 33]);
        *(GAS v4u*)(WT + (size_t)rm(n0 + n) * K + k0 + 8 * c) = o; }
    LDS_WAIT(); asm volatile("" ::: "memory");
}
struct RmId { __device__ __forceinline__ int operator()(int n) const { return n; } };
struct RmQ {
    __device__ __forceinline__ int operator()(int n) const { const int h = n / 96, j = n % 96; if (j < 64) return n; const int i = j - 64; return h * 96 + 64 + ((i < 16) ? 2 * i : 2 * (i - 16) + 1); }
};

__device__ __forceinline__ int lane_id_opaque() { int l; asm volatile("v_mbcnt_lo_u32_b32 %0, -1, 0\n\tv_mbcnt_hi_u32_b32 %0, -1, %0" : "=v"(l)); return l; }
typedef const __attribute__((address_space(4))) unsigned char* kargp_t;
__device__ __forceinline__ kargp_t karg_opaque(int off) { kargp_t k = (kargp_t)__builtin_amdgcn_kernarg_segment_ptr(); asm volatile("" : "+s"(k)); return k + off; }
template <class T> __device__ __forceinline__ T karg_ld(int off) { typedef T const __attribute__((address_space(4))) * P; return *(P)karg_opaque(off); }
struct Args { const void* in[25]; float* out; unsigned char* ws; int ph_lo, ph_hi, li, pad; };

__device__ __constant__ float c_invfreq[16] = {
    1.0f, 0.5623413251903491f, 0.31622776601683794f, 0.1778279410038923f, 0.1f, 0.05623413251903491f, 0.03162277660168379f, 0.01778279410038923f,
    0.01f, 0.005623413251903491f, 0.0031622776601683794f, 0.0017782794100389228f, 0.001f, 0.0005623413251903491f, 0.00031622776601683794f, 0.00017782794100389227f };

__device__ __forceinline__ void ln_row(const float* a, const float* b, const float* g, const float* be, float* of, bf16* ob, int lane) {
    const GAS f32x4* ar = (const GAS f32x4*)a + lane; const GAS f32x4* br = (const GAS f32x4*)b + lane;
    f32x4 v[4]; float s = 0.f;
#pragma unroll
    for (int j = 0; j < 4; ++j) { v[j] = ar[64 * j] * ALPHA + br[64 * j]; s += (v[j].x + v[j].y) + (v[j].z + v[j].w); }
    const float mean = wave_sum(s) * (1.f / DM); float s2 = 0.f;
#pragma unroll
    for (int j = 0; j < 4; ++j) { v[j] = v[j] - mean; s2 += (v[j].x * v[j].x + v[j].y * v[j].y) + (v[j].z * v[j].z + v[j].w * v[j].w); }
    const float rstd = 1.f / sqrtf(wave_sum(s2) * (1.f / DM) + LN_EPS);
#pragma unroll
    for (int j = 0; j < 4; ++j) { const f32x4 gg = ((const GAS f32x4*)g)[lane + 64 * j], bb = ((const GAS f32x4*)be)[lane + 64 * j]; const f32x4 o = v[j] * rstd * gg + bb;
        ((GAS f32x4*)of)[lane + 64 * j] = o;
        if (ob) ((GAS unsigned long long*)ob)[lane + 64 * j] = (unsigned long long)pk2(o.x, o.y) | ((unsigned long long)pk2(o.z, o.w) << 32); }
}

enum { PH_PRO = 0, PH_HGEMM, PH_R1, PH_R2, PH_R3, PH_MLAPREP, PH_QGEMM, PH_KVGEMM, PH_ATTN, PH_OUTGEMM, PH_LN1, PH_F1, PH_F2, PH_LN2, PH_COUNT };

__global__ void __launch_bounds__(NWAVES * 64, 2) skel_fwd(Args args) {
    extern __shared__ __attribute__((aligned(16))) unsigned char lds[];
    Frame F;
    F.lds = (LAS unsigned char*)lds;
    F.wave = __builtin_amdgcn_readfirstlane(threadIdx.x >> 6);
#define LANE_() lane_id_opaque()
#define TID_() (F.wave * 64 + LANE_())
    F.G = gridDim.x; { const int bx = blockIdx.x; F.vcu = (F.G % 8 == 0) ? (bx % 8) * (F.G / 8) + bx / 8 : bx; }
#define KARG_(T, off) karg_ld<T>(off)
#define INF(i) KARG_(const float*, 8 * (i))
#define ARG_WS_ KARG_(unsigned char*, offsetof(Args, ws))
#define ARG_OUT_ KARG_(float*, offsetof(Args, out))
#define WSB(off) ((bf16*)(ARG_WS_ + (off)))
#define WSF(off) ((float*)(ARG_WS_ + (off)))
    for (int u = TID_(); u < (LDS_BYTES - LDSCTL_OFF) / 4; u += NWAVES * 64) ((LAS unsigned*)(F.lds + LDSCTL_OFF))[u] = 0u;
    __syncthreads();
#define PLO_ KARG_(int, offsetof(Args, ph_lo))
#define PHI_ KARG_(int, offsetof(Args, ph_hi))
    if ((PHI_ - PLO_) > 1) (void)xcd_barrier_post((unsigned*)((gu32*)(ARG_WS_ + WS_CTL) + CW_BAR), (volatile LAS unsigned*)(F.lds + MISC_OFF) + 8, TID_() == 0);
#ifndef PH_MASK
#define PH_MASK 0xffff
#endif
#define IN(k) (((PH_MASK >> (k)) & 1) && PLO_ <= (k) && (k) < PHI_)
#define SEAM(k) do { if (IN(k) && IN((k) + 1)) { XcdBarrier bar_; bar_.bar = (unsigned*)((gu32*)(ARG_WS_ + WS_CTL) + CW_BAR); bar_.x = xb_xcc_id(); bar_.st = (volatile LAS unsigned*)(F.lds + MISC_OFF) + 8; xcd_barrier(bar_, TID_() == 0); } } while (0)
#define gw (F.vcu * NWAVES + F.wave)
#define NGW (F.G * NWAVES)

    if (IN(PH_PRO)) {
        LAS float* scr = (LAS float*)(F.lds + RING_OFF + F.wave * 16384);
        constexpr int I_IN = (DM / 64) * (IN_COLS / 32), I_UQ = (QL / 64) * (NQ / 32), I_UKV = (KVL / 64) * (NKV / 32), I_OUT = (DM / 64) * (DM / 32), I_F1 = (DM / 64) * (FF / 32), I_F2 = (FF / 64) * (DM / 32);
        constexpr int I_W2 = 16, I_A2 = 16, I_G2 = 32;
        constexpr int NITEMS = I_IN + I_UQ + I_UKV + I_OUT + I_F1 + I_F2 + I_W2 + I_A2 + I_G2;
        for (int it = gw; it < NITEMS; it += NGW) {
            int r = it;
            if (r < I_IN) { p0_transpose_item(INF(2), DM, IN_COLS, WSB(WS_WIN), nullptr, RmId(), scr, r, LANE_()); continue; } r -= I_IN;
            if (r < I_UQ) { p0_transpose_item(INF(15), QL, NQ, WSB(WS_WUQ), INF(14), RmQ(), scr, r, LANE_(), ATT_C2); continue; } r -= I_UQ;
            if (r < I_UKV) { p0_transpose_item(INF(17), KVL, NKV, WSB(WS_WUKV), INF(16), RmId(), scr, r, LANE_()); continue; } r -= I_UKV;
            if (r < I_OUT) { p0_transpose_item(INF(18), DM, DM, WSB(WS_WOUT), nullptr, RmId(), scr, r, LANE_()); continue; } r -= I_OUT;
            if (r < I_F1) { p0_transpose_item(INF(21), DM, FF, WSB(WS_WF1), nullptr, RmId(), scr, r, LANE_()); continue; } r -= I_F1;
            if (r < I_F2) { p0_transpose_item(INF(22), FF, DM, WSB(WS_WF2), nullptr, RmId(), scr, r, LANE_()); continue; } r -= I_F2;
            if (r < I_W2) { p0_transpose_item(INF(5), 64, 512, WSB(WS_W2T), nullptr, RmId(), scr, r, LANE_()); continue; } r -= I_W2;
            if (r < I_A2) { p0_transpose_item(INF(7), 64, 512, WSB(WS_A2T), nullptr, RmId(), scr, r, LANE_()); continue; } r -= I_A2;
            p0_transpose_item(INF(8), 128, 512, WSB(WS_G2T), nullptr, RmId(), scr, r, LANE_());
        }
        { float* CT = WSF(WS_CT); const int i = F.vcu * (NWAVES * 64) + TID_();
          if (i < 512) { const float* mu = INF(3); float* o = CT + i * rw::CT_STRIDE; o[0] = mu[i]; o[1] = mu[512 + i]; o[2] = mu[1024 + i]; o[3] = INF(4)[i]; o[4] = INF(6)[i]; o[5] = INF(9)[i]; o[6] = INF(10)[i]; o[7] = INF(11)[i];
                         o[8] = INF(12)[i]; o[9] = INF(13)[i]; o[10] = 0.f; o[11] = 0.f; }
          else if (i < 768) CT[rw::CT_MUX + (i - 512)] = INF(3)[1536 + (i - 512)]; }
        { const size_t n16 = (size_t)(HP - IN_COLS) * DM * 2 / 16; GAS v4u* z = (GAS v4u*)(WSB(WS_WIN) + (size_t)IN_COLS * DM);
          for (size_t i = (size_t)F.vcu * (NWAVES * 64) + TID_(); i < n16; i += (size_t)F.G * NWAVES * 64) z[i] = (v4u){0u, 0u, 0u, 0u}; }
        { const size_t n8 = (size_t)M * DM / 8; const GAS f32x4* xs = (const GAS f32x4*)INF(0); GAS v4u* xd = (GAS v4u*)WSB(WS_XB);
          for (size_t i = (size_t)F.vcu * (NWAVES * 64) + TID_(); i < n8; i += (size_t)F.G * NWAVES * 64) { const f32x4 a = xs[2 * i], b = xs[2 * i + 1];
              v4u o; o.x = pk2(a.x, a.y); o.y = pk2(a.z, a.w); o.z = pk2(b.x, b.y); o.w = pk2(b.z, b.w); xd[i] = o; } }
    }
    SEAM(PH_PRO);
    if (IN(PH_HGEMM)) {
        pg8::Gemm g{WSB(WS_XB), WSB(WS_WIN), M, HP, DM, DM}; pg8::StaticOrder S; S.init(M, HP, F.G, (int)blockIdx.x);
        pg8::EpiBf16<0> E{WSB(WS_HB), HP};
        pg8::gemm_phase<pg8::EpiBf16<0>, pg8::StaticOrder, true, true>(F.lds + RING_OFF, g, S, E, TID_());
    }
    SEAM(PH_HGEMM);
    if (IN(PH_R1)) {
        rw::R1Params rp{WSB(WS_HB), WSF(WS_CT), WSB(WS_W2T), ARG_WS_ + WS_REC};
        for (int id = F.vcu; id < 4096; id += F.G) rw::r1_unit(rp, id >> 9, id & 7, (id >> 3) & 63, F.lds + RING_OFF, TID_());
    }
    SEAM(PH_R1);
    if (IN(PH_R2)) { if (F.vcu < 128 && F.wave == 0) rw::r2_task(ARG_WS_ + WS_REC, F.vcu >> 1, F.vcu & 1, LANE_()); }
    SEAM(PH_R2);
    if (IN(PH_R3)) { for (int task = gw; task < 8192; task += NGW) rw::r3_task(ARG_WS_ + WS_REC, WSB(WS_CAT), task >> 1, task & 1, LANE_()); }
    SEAM(PH_R3);
    if (IN(PH_MLAPREP)) {
        float* COS = WSF(WS_COS); float* SIN = WSF(WS_SIN); bf16* KB = WSB(WS_K); const int* positions = (const int*)KARG_(const void*, 8);
        for (int m = gw; m < M; m += NGW) {
            const bf16* hr = WSB(WS_HB) + (size_t)m * HP;
            float sq = 0.f, skv = 0.f; float vq[6], vk[4]; const int ln = LANE_();
#pragma unroll
            for (int j = 0; j < 6; ++j) { vq[j] = bf2f(hr[CQ_OFF + ln + 64 * j]); sq += vq[j] * vq[j]; }
#pragma unroll
            for (int j = 0; j < 4; ++j) { vk[j] = bf2f(hr[CKV_OFF + ln + 64 * j]); skv += vk[j] * vk[j]; }
            sq = wave_sum(sq); skv = wave_sum(skv);
            const float rq = 1.0f / sqrtf(sq * (1.f / QL) + RMS_EPS), rk = 1.0f / sqrtf(skv * (1.f / KVL) + RMS_EPS);
            bf16* hw = WSB(WS_HB) + (size_t)m * HP;
#pragma unroll
            for (int j = 0; j < 6; ++j) hw[CQ_OFF + ln + 64 * j] = (bf16)f2bf(vq[j] * rq);
#pragma unroll
            for (int j = 0; j < 4; ++j) hw[CKV_OFF + ln + 64 * j] = (bf16)f2bf(vk[j] * rk);
            if (LANE_() < 16) {
                const int i = LANE_(); const float ang = (float)positions[m] * c_invfreq[i]; float sn, cs; sincosf(ang, &sn, &cs);
                COS[(size_t)m * 16 + i] = cs; SIN[(size_t)m * 16 + i] = sn;
                const float z1 = bf2f(hr[KPE_OFF + i]), z2 = bf2f(hr[KPE_OFF + 16 + i]);
                const unsigned w = pk2(z1 * cs - z2 * sn, z2 * cs + z1 * sn);
#pragma unroll
                for (int h = 0; h < 8; ++h) *(GAS unsigned*)(KB + (size_t)m * 768 + h * 96 + 64 + 2 * i) = w;
            }
        }
    }
    SEAM(PH_MLAPREP);
    if (IN(PH_QGEMM)) {
        pg8::Gemm g{WSB(WS_HB) + CQ_OFF, WSB(WS_WUQ), M, NQ, QL, HP}; pg8::StaticOrder S; S.init(M, NQ, F.G, (int)blockIdx.x);
        pg8::EpiBf16<0> E{WSB(WS_Q), NQ};
        pg8::gemm_phase<pg8::EpiBf16<0>, pg8::StaticOrder, true, true>(F.lds + RING_OFF, g, S, E, TID_());
    }
    SEAM(PH_QGEMM);
    if (IN(PH_KVGEMM)) {
        pg8::Gemm g{WSB(WS_HB) + CKV_OFF, WSB(WS_WUKV), M, NKV, KVL, HP}; pg8::StaticOrder S; S.init(M, NKV, F.G, (int)blockIdx.x);
        pg8::EpiKV E{WSB(WS_K), WSB(WS_V)};
        pg8::gemm_phase<pg8::EpiKV, pg8::StaticOrder, true, true>(F.lds + RING_OFF, g, S, E, TID_());
    }
    SEAM(PH_KVGEMM);
    if (IN(PH_ATTN)) {
        for (int i = 0; i < 4; ++i) {
            const int bh = F.vcu >> 2, s = F.vcu & 3; const int qb = (i == 0) ? s : (i == 1) ? 7 - s : (i == 2) ? 8 + s : 15 - s;
            if (F.vcu < 256) att::attn_unit(bh >> 3, bh & 7, qb, WSB(WS_Q), WSB(WS_K), WSB(WS_V), WSB(WS_CAT), WSF(WS_COS), WSF(WS_SIN), F.lds + RING_OFF, TID_());
        }
    }
    SEAM(PH_ATTN);
    if (IN(PH_OUTGEMM)) {
        pg8::Gemm g{WSB(WS_CAT), WSB(WS_WOUT), M, DM, DM, DM}; pg8::StaticOrder S; S.init(M, DM, F.G, (int)blockIdx.x);
        pg8::EpiF32 E{WSF(WS_MIX), DM};
        pg8::gemm_phase<pg8::EpiF32, pg8::StaticOrder, true, true>(F.lds + RING_OFF, g, S, E, TID_());
    }
    SEAM(PH_OUTGEMM);
    if (IN(PH_LN1)) { for (int m = gw; m < M; m += NGW) ln_row(INF(0) + (size_t)m * DM, WSF(WS_MIX) + (size_t)m * DM, INF(19), INF(20), ARG_OUT_ + (size_t)m * DM, WSB(WS_X1B) + (size_t)m * DM, LANE_()); }
    SEAM(PH_LN1);
    if (IN(PH_F1)) {
        pg8::Gemm g{WSB(WS_X1B), WSB(WS_WF1), M, FF, DM, DM}; pg8::StaticOrder S; S.init(M, FF, F.G, (int)blockIdx.x);
        pg8::EpiBf16<2> E{WSB(WS_HID), FF};
        pg8::gemm_phase<pg8::EpiBf16<2>, pg8::StaticOrder, true, true>(F.lds + RING_OFF, g, S, E, TID_());
    }
    SEAM(PH_F1);
    if (IN(PH_F2)) {
        pg8::Gemm g{WSB(WS_HID), WSB(WS_WF2), M, DM, FF, FF}; pg8::StaticOrder S; S.init(M, DM, F.G, (int)blockIdx.x);
        pg8::EpiF32 E{WSF(WS_MIX), DM};
        pg8::gemm_phase<pg8::EpiF32, pg8::StaticOrder, true, true>(F.lds + RING_OFF, g, S, E, TID_());
    }
    SEAM(PH_F2);
    if (IN(PH_LN2)) { for (int m = gw; m < M; m += NGW) ln_row(ARG_OUT_ + (size_t)m * DM, WSF(WS_MIX) + (size_t)m * DM, INF(23), INF(24), ARG_OUT_ + (size_t)m * DM, nullptr, LANE_()); }
#undef IN
#undef SEAM
#undef PLO_
#undef PHI_
#undef gw
#undef NGW
}
extern "C" void kernel_launch(void* const* d_in, const int* in_sizes, int n_in, void* d_out, int out_size, void* d_ws, size_t ws_size, hipStream_t stream) {
    static int grid = 0;
    if (grid == 0) {
        if (n_in != 25 || in_sizes[0] != M * DM || out_size != M * DM || ws_size < WS_END) { fprintf(stderr, "kernel_launch: unexpected shapes: n_in %d in0 %d out %d ws %zu\n", n_in, n_in > 0 ? in_sizes[0] : -1, out_size, ws_size); grid = -1; return; }
        int dev = 0, cus = 0;
        if (hipGetDevice(&dev) != hipSuccess || hipDeviceGetAttribute(&cus, hipDeviceAttributeMultiprocessorCount, dev) != hipSuccess) { grid = -1; return; }
        if (hipFuncSetAttribute((const void*)skel_fwd, hipFuncAttributeMaxDynamicSharedMemorySize, LDS_BYTES) != hipSuccess) { fprintf(stderr, "kernel_launch: hipFuncSetAttribute failed\n"); grid = -1; return; }
        (void)hipGetLastError();
        grid = cus;
        if (grid != 256) fprintf(stderr, "kernel_launch: %d CUs (expected 256)\n", grid);
    }
    if (grid < 0) return;
    (void)hipMemsetAsync((char*)d_ws + WS_CTL, 0, CTL_ZERO_BYTES, stream);
    Args a{};
    for (int i = 0; i < 25; ++i) a.in[i] = d_in[i];
    a.out = (float*)d_out; a.ws = (unsigned char*)d_ws;
    a.ph_lo = 0; a.ph_hi = PH_COUNT; a.li = 0;
    hipLaunchKernelGGL(skel_fwd, dim3(grid), dim3(NWAVES * 64), LDS_BYTES, stream, a);
}
```
